# Optimizing an MI355X kernel written in HIP

```python
import jax, jax.numpy as jnp
from jax import lax
import numpy as np

D_MODEL = 1024
BATCH = 8
SEQ = 2048
DEPTH = 1

N_META = 16
CHUNK = 128
EPS = 1e-6

M_HEADS = 4
M_DQK = 128
M_DV = 256
M_QK = M_HEADS * M_DQK
M_V = M_HEADS * M_DV
GATE_CAP = 15.0

S_HEADDIM = 64
S_INNER = D_MODEL
S_HEADS = S_INNER // S_HEADDIM
S_GROUPS = 4
S_HPG = S_HEADS // S_GROUPS
S_STATE = 128
S_CONV = 4
S_XBC = S_INNER + 2 * S_GROUPS * S_STATE

D_FF = -(-8 * D_MODEL // (3 * 256)) * 256

IN_SIZES = (M_QK, M_QK, M_V, M_V, M_HEADS, M_HEADS, S_INNER, S_XBC, S_HEADS, D_MODEL, D_MODEL)
IN_WIDTH = sum(IN_SIZES)

kernel_name = 'hybrid_mlstm_ssd_gated_block'


def rmsnorm(x, g):
    xf = x.astype(jnp.float32)
    y = xf * lax.rsqrt(jnp.mean(xf * xf, axis=-1, keepdims=True) + EPS)
    return (y * g.astype(jnp.float32)).astype(x.dtype)


def softcap(a):
    return GATE_CAP * jnp.tanh(a / GATE_CAP)


def _mlstm_state_step(carry, inp):
    C, n, m = carry
    b_tot, m_loc, S_loc, n_loc = inp
    m_new = jnp.maximum(b_tot + m, m_loc)
    a = jnp.exp(b_tot + m - m_new)
    s = jnp.exp(m_loc - m_new)
    C_new = a[..., None, None] * C + s[..., None, None] * S_loc
    n_new = a[..., None] * n + s[..., None] * n_loc
    return (C_new, n_new, m_new), (C, n, m)


def mlstm_chunked(q, k, v, i_pre, f_pre, valid):
    Bsz, T, H, Dk = q.shape
    Dv = v.shape[-1]
    nc = T // CHUNK
    f32 = jnp.float32
    vmask = valid[None, :, None]
    i_log = jnp.where(vmask, softcap(i_pre.astype(f32)), -jnp.inf)
    f_log = jnp.where(vmask, jax.nn.log_sigmoid(softcap(f_pre.astype(f32))), 0.0)
    q = (q * (Dk ** -0.5)).reshape(Bsz, nc, CHUNK, H, Dk)
    k = k.reshape(Bsz, nc, CHUNK, H, Dk)
    v = v.reshape(Bsz, nc, CHUNK, H, Dv)
    it = jnp.moveaxis(i_log.reshape(Bsz, nc, CHUNK, H), 2, -1)
    bt = jnp.cumsum(jnp.moveaxis(f_log.reshape(Bsz, nc, CHUNK, H), 2, -1), axis=-1)
    b_tot = bt[..., -1]
    causal = jnp.tril(jnp.ones((CHUNK, CHUNK), dtype=bool))
    d_log = jnp.where(causal, bt[..., :, None] - bt[..., None, :] + it[..., None, :], -jnp.inf)

    w_end = b_tot[..., None] - bt + it
    m_loc = jnp.max(w_end, axis=-1)
    wgt = jnp.exp(w_end - m_loc[..., None])
    vw = v * jnp.moveaxis(wgt, -1, 2)[..., None]
    S_loc = jnp.einsum('bcshv,bcshk->bchvk', vw, k)
    n_loc = jnp.einsum('bchs,bcshk->bchk', wgt, k)

    init = (jnp.zeros((Bsz, H, Dv, Dk), f32), jnp.zeros((Bsz, H, Dk), f32), jnp.zeros((Bsz, H), f32))
    xs = (jnp.moveaxis(b_tot, 1, 0), jnp.moveaxis(m_loc, 1, 0),
          jnp.moveaxis(S_loc.astype(f32), 1, 0), jnp.moveaxis(n_loc.astype(f32), 1, 0))
    _, (C_prev, n_prev, m_prev) = lax.scan(_mlstm_state_step, init, xs)
    C_prev = jnp.moveaxis(C_prev, 0, 1)
    n_prev = jnp.moveaxis(n_prev, 0, 1)
    m_prev = jnp.moveaxis(m_prev, 0, 1)

    inter_log = bt + m_prev[..., None]
    m_t = jnp.maximum(inter_log, jnp.max(d_log, axis=-1))
    qk = jnp.einsum('bcthk,bcshk->bchts', q, k)
    w_ts = jnp.exp(d_log - m_t[..., None]) * qk
    inter = jnp.exp(inter_log - m_t)
    num = (jnp.einsum('bchts,bcshv->bcthv', w_ts, v)
           + jnp.einsum('bchvk,bcthk->bcthv', C_prev, q) * jnp.moveaxis(inter, -1, 2)[..., None])
    den = jnp.sum(w_ts, axis=-1) + inter * jnp.einsum('bchk,bcthk->bcht', n_prev, q)
    denom = jnp.maximum(jnp.abs(den), jnp.exp(-m_t))
    h = num / jnp.moveaxis(denom, -1, 2)[..., None]
    return h.reshape(Bsz, T, H, Dv).astype(v.dtype)


def _ssd_state_step(S, inp):
    decay, st = inp
    return decay[..., None, None] * S + st, S


def ssd_chunked(x, dt, A, Bm, Cm):
    Bsz, T, G, J, P = x.shape
    N = Bm.shape[-1]
    nc = T // CHUNK
    x = x.reshape(Bsz, nc, CHUNK, G, J, P)
    dt = dt.reshape(Bsz, nc, CHUNK, G, J)
    Bm = Bm.reshape(Bsz, nc, CHUNK, G, N)
    Cm = Cm.reshape(Bsz, nc, CHUNK, G, N)
    cum = jnp.cumsum(dt * A, axis=2)
    ct = jnp.moveaxis(cum, 2, -1)
    dtT = jnp.moveaxis(dt, 2, -1)
    causal = jnp.tril(jnp.ones((CHUNK, CHUNK), dtype=bool))
    decay = jnp.exp(jnp.where(causal, ct[..., :, None] - ct[..., None, :], -jnp.inf))
    cb = jnp.einsum('bctgn,bcsgn->bcgts', Cm, Bm)
    w = cb[:, :, :, None] * decay * dtT[..., None, :]
    y_diag = jnp.einsum('bcgjts,bcsgjp->bctgjp', w, x)

    end_w = jnp.exp(ct[..., -1:] - ct) * dtT
    xw = x * jnp.moveaxis(end_w, -1, 2)[..., None]
    states = jnp.einsum('bcsgn,bcsgjp->bcgjpn', Bm, xw)
    chunk_decay = jnp.exp(ct[..., -1])
    init = jnp.zeros((Bsz, G, J, P, N), jnp.float32)
    _, S_prev = lax.scan(_ssd_state_step, init,
                         (jnp.moveaxis(chunk_decay, 1, 0), jnp.moveaxis(states.astype(jnp.float32), 1, 0)))
    S_prev = jnp.moveaxis(S_prev, 0, 1)
    y_off = jnp.einsum('bctgn,bcgjpn->bctgjp', Cm, S_prev) * jnp.exp(cum)[..., None]
    return (y_diag + y_off).reshape(Bsz, T, G, J, P)


def setup_inputs(seed: int = 0) -> dict:
    key = jax.random.key(seed)
    ks = jax.random.split(key, 24)
    f32 = jnp.float32
    nrm = lambda k, shape, scale: jax.random.normal(k, shape, f32) * scale
    dt0 = jnp.exp(jax.random.uniform(ks[10], (DEPTH, S_HEADS), f32) * (np.log(0.1) - np.log(1e-3)) + np.log(1e-3))
    return {
        'x': nrm(ks[0], (BATCH, SEQ, D_MODEL), 1.0),
        'meta': nrm(ks[1], (N_META, D_MODEL), 1.0),
        'norm1_g': 1.0 + nrm(ks[2], (DEPTH, D_MODEL), 0.05),
        'w_in': nrm(ks[3], (DEPTH, D_MODEL, IN_WIDTH), D_MODEL ** -0.5),
        'm_igate_b': nrm(ks[4], (DEPTH, M_HEADS), 0.1),
        'm_fgate_b': jnp.linspace(3.0, 6.0, M_HEADS, dtype=f32)[None] + nrm(ks[5], (DEPTH, M_HEADS), 0.1),
        'm_norm_g': 1.0 + nrm(ks[6], (DEPTH, M_HEADS, M_DV), 0.05),
        'm_proj': nrm(ks[7], (DEPTH, M_V, D_MODEL), M_V ** -0.5),
        's_conv_w': nrm(ks[8], (DEPTH, S_CONV, S_XBC), S_CONV ** -0.5),
        's_conv_b': nrm(ks[9], (DEPTH, S_XBC), 0.02),
        's_dt_bias': dt0 + jnp.log(-jnp.expm1(-dt0)),
        's_A_log': jnp.log(jax.random.uniform(ks[11], (DEPTH, S_HEADS), f32, 1.0, 16.0)),
        's_D': 1.0 + nrm(ks[12], (DEPTH, S_HEADS), 0.1),
        's_norm_g': 1.0 + nrm(ks[13], (DEPTH, S_INNER), 0.05),
        's_proj': nrm(ks[14], (DEPTH, S_INNER, D_MODEL), S_INNER ** -0.5),
        'w_out': nrm(ks[15], (DEPTH, D_MODEL, D_MODEL), D_MODEL ** -0.5),
        'norm2_g': 1.0 + nrm(ks[16], (DEPTH, D_MODEL), 0.05),
        'w_ffn_in': nrm(ks[17], (DEPTH, D_MODEL, 2 * D_FF), D_MODEL ** -0.5),
        'w_ffn_out': nrm(ks[18], (DEPTH, D_FF, D_MODEL), D_FF ** -0.5),
        'norm_f_g': 1.0 + nrm(ks[19], (D_MODEL,), 0.05),
    }


def reference(x, meta, norm1_g, w_in, m_igate_b, m_fgate_b, m_norm_g, m_proj, s_conv_w, s_conv_b,
              s_dt_bias, s_A_log, s_D, s_norm_g, s_proj, w_out, norm2_g, w_ffn_in, w_ffn_out, norm_f_g):
    Bsz, S, Dm = x.shape
    n_pad = CHUNK - N_META
    T = S + CHUNK
    h = jnp.concatenate([jnp.zeros((Bsz, n_pad, Dm), x.dtype),
                         jnp.broadcast_to(meta[None].astype(x.dtype), (Bsz, N_META, Dm)),
                         x], axis=1)
    valid = jnp.arange(T) >= n_pad
    split_at = tuple(int(i) for i in np.cumsum(IN_SIZES)[:-1])

    for l in range(DEPTH):
        u = rmsnorm(h, norm1_g[l])
        proj = u @ w_in[l]
        q, k, v, o_pre, i_pre, f_pre, z, xbc, dt_raw, ga, gb = jnp.split(proj, split_at, axis=-1)

        hm = mlstm_chunked(q.reshape(Bsz, T, M_HEADS, M_DQK), k.reshape(Bsz, T, M_HEADS, M_DQK),
                           v.reshape(Bsz, T, M_HEADS, M_DV), i_pre + m_igate_b[l], f_pre + m_fgate_b[l], valid)
        hm = rmsnorm(hm, m_norm_g[l]).reshape(Bsz, T, M_V) * jax.nn.sigmoid(o_pre)
        branch_a = hm @ m_proj[l]

        xbc = xbc * valid[None, :, None].astype(xbc.dtype)
        xpad = jnp.pad(xbc, ((0, 0), (S_CONV - 1, 0), (0, 0)))
        conv = s_conv_b[l] + sum(xpad[:, j:j + T] * s_conv_w[l, j] for j in range(S_CONV))
        xbc = jax.nn.silu(conv)
        xs, Bm, Cm = jnp.split(xbc, (S_INNER, S_INNER + S_GROUPS * S_STATE), axis=-1)
        xs = xs.reshape(Bsz, T, S_GROUPS, S_HPG, S_HEADDIM)
        dt = jax.nn.softplus(dt_raw.astype(jnp.float32) + s_dt_bias[l].astype(jnp.float32))
        dt = jnp.where(valid[None, :, None], dt, 0.0).reshape(Bsz, T, S_GROUPS, S_HPG)
        A = -jnp.exp(s_A_log[l].astype(jnp.float32)).reshape(S_GROUPS, S_HPG)
        ys = ssd_chunked(xs, dt, A, Bm.reshape(Bsz, T, S_GROUPS, S_STATE), Cm.reshape(Bsz, T, S_GROUPS, S_STATE))
        ys = ys + s_D[l].reshape(S_GROUPS, S_HPG)[..., None] * xs
        ys = (ys.reshape(Bsz, T, S_INNER) * jax.nn.silu(z)).astype(x.dtype)
        ys = rmsnorm(ys.reshape(Bsz, T, S_GROUPS, S_INNER // S_GROUPS),
                     s_norm_g[l].reshape(S_GROUPS, S_INNER // S_GROUPS)).reshape(Bsz, T, S_INNER)
        branch_b = ys @ s_proj[l]

        merged = jax.nn.sigmoid(ga) * branch_a + jax.nn.sigmoid(gb) * branch_b
        h = h + (merged @ w_out[l]).astype(h.dtype)

        u2 = rmsnorm(h, norm2_g[l])
        g_in, up = jnp.split(u2 @ w_ffn_in[l], 2, axis=-1)
        h = h + ((jax.nn.silu(g_in) * up) @ w_ffn_out[l]).astype(h.dtype)

    out = rmsnorm(h, norm_f_g)[:, CHUNK:]
    return out.astype(x.dtype)
```

```cpp
#include <hip/hip_runtime.h>
#include <hip/hip_cooperative_groups.h>
#include <cstdio>
#include <cstdint>
namespace cg = cooperative_groups;
namespace pg8 {
#define PG8_LAS __attribute__((address_space(3)))
typedef unsigned short bf16_t;
typedef short bf16x8 __attribute__((ext_vector_type(8)));
typedef float f32x4 __attribute__((ext_vector_type(4)));
typedef unsigned u32x4 __attribute__((ext_vector_type(4)));
constexpr int BM = 256, BK = 64, HALF = 128, HTB = HALF * BK * 2  , STAGE_BYTES = 8 * HTB, NXCD = 8, WGM = 8;

__host__ __device__ __forceinline__ int lds_byte(int r, int c) { const int st = (r >> 4) * 2 + (c >> 5), rr = r & 15, cc = c & 31, ob = rr * 64 + cc * 2; return st * 1024 + (ob ^ (((ob >> 9) & 1) << 5)); }
__host__ __device__ __forceinline__ void stage_rc(int b, int& R, int& C) { const int st = b / 1024, sb = b % 1024, swz = sb ^ (((sb >> 9) & 1) << 5); R = (st >> 1) * 16 + swz / 64; C = (st & 1) * 32 + (swz % 64) / 2; }
__host__ __device__ __forceinline__ int perm32(int rho) { const int n = rho >> 4, i = rho & 15; return 8 * (i >> 2) + 4 * n + (i & 3); }

struct Unit { int pm, pn; };
struct Gemm { const bf16_t* A; const bf16_t* Bt; int M, N, K, lda; };

struct StaticOrder {
    int nM, nN, nwg, G, c;
    __host__ __device__ void init(int M, int N, int G_, int c_) { nM = M / BM; nN = N / BM; nwg = nM * nN; G = G_; c = c_; }
    __host__ __device__ bool next(int i, Unit& u) const {
        const long L = (long)i * G + c; if (L >= nwg) return false;
        int wgid = (int)L; { const int q = nwg / NXCD, r = nwg % NXCD, xcd = wgid % NXCD, off = wgid / NXCD; wgid = (xcd < r ? xcd * (q + 1) : r * (q + 1) + (xcd - r) * q) + off; }
        const int nig = WGM * nN, gid = wgid / nig, fm = gid * WGM, gsz = (nM - fm) < WGM ? (nM - fm) : WGM;
        u.pm = fm + ((wgid % nig) % gsz); u.pn = (wgid % nig) / gsz; return true;
    }
    __device__ __forceinline__ void a_ready(const Unit&) const {}
    __device__ __forceinline__ void done(const Unit&) const {}
};

__device__ __forceinline__ unsigned cvt_pk_bf16(float lo, float hi) { unsigned r; asm volatile("v_cvt_pk_bf16_f32 %0, %1, %2" : "=v"(r) : "v"(lo), "v"(hi)); return r; }
template <class Epi, class Sched, bool ALIGN_EPI = false, bool SP2 = false>
__device__ __forceinline__ void gemm_phase(PG8_LAS unsigned char* lds, const Gemm g, const Sched& S, const Epi& E) {
    const int tid = threadIdx.x, wid = __builtin_amdgcn_readfirstlane(tid >> 6), lane = tid & 63, wr = wid >> 2, wc = wid & 3, fr = lane & 15, fq = lane >> 4;
    const int K = g.K, nt = K / BK;
    unsigned voffA[2], voffB[2];
#pragma unroll
    for (int i = 0; i < 2; ++i) { int R, C; stage_rc(tid * 16 + i * 8192, R, C); const int Rb = Epi::PERM ? ((R & ~31) + perm32(R & 31)) : R;
        voffA[i] = (unsigned)(R * g.lda + C) * 2u; voffB[i] = (unsigned)(Rb * K + C) * 2u; }
    const size_t kstep = (size_t)(BK * 2);
    const size_t hstep = (size_t)HALF * K * 2; const size_t hstepA = (size_t)HALF * g.lda * 2;
    const size_t tstep = 2 * hstep; const size_t tstepA = 2 * hstepA;
    const unsigned ldsw = (unsigned)wid * 1024u;
    const int aoff = lds_byte(wr * 64 + fr, fq * 8), boff = lds_byte(wc * 32 + fr, fq * 8);
#define PG8_SA(b, h) (((b) * 2 + (h)) * HTB)
#define PG8_SB(b, h) ((4 + (b) * 2 + (h)) * HTB)
#define PG8_STAGE(bufoff, gbase, voff) do { _Pragma("unroll") for (int _i = 0; _i < 2; ++_i) \
        __builtin_amdgcn_global_load_lds((const unsigned*)((const char*)(gbase) + (voff)[_i]), (PG8_LAS unsigned*)(lds + (bufoff) + ldsw + _i * 8192), 16, 0, 0); } while (0)
#define PG8_LDA(dst, b, h) do { _Pragma("unroll") for (int m = 0; m < 4; ++m) _Pragma("unroll") for (int k = 0; k < 2; ++k) dst[m][k] = *(const PG8_LAS bf16x8*)(lds + PG8_SA(b, h) + aoff + m * 2048 + k * 1024); } while (0)
#define PG8_LDB(dst, b, h) do { _Pragma("unroll") for (int n = 0; n < 2; ++n) _Pragma("unroll") for (int k = 0; k < 2; ++k) dst[n][k] = *(const PG8_LAS bf16x8*)(lds + PG8_SB(b, h) + boff + n * 2048 + k * 1024); } while (0)
#define PG8_MMA(ai, bj, At, Bt) do { __builtin_amdgcn_s_setprio(1); _Pragma("unroll") for (int m = 0; m < 4; ++m) _Pragma("unroll") for (int n = 0; n < 2; ++n) _Pragma("unroll") for (int k = 0; k < 2; ++k) \
        acc[ai][bj][m][n] = __builtin_amdgcn_mfma_f32_16x16x32_bf16(Bt[n][k], At[m][k], acc[ai][bj][m][n], 0, 0, 0); __builtin_amdgcn_s_setprio(0); } while (0)
#define PG8_WAIT_V(n) asm volatile("s_waitcnt vmcnt(" #n ")" ::: "memory")
#define PG8_WAIT_L(n) asm volatile("s_waitcnt lgkmcnt(" #n ")" ::: "memory")
#define PG8_BAR __builtin_amdgcn_s_barrier()
#define PG8_SCHED __builtin_amdgcn_sched_barrier(0)
    Unit cur, nxt; int ui = 0;
    if (!S.next(0, cur)) return;
    f32x4 acc[2][2][4][2];
#pragma unroll
    for (int a = 0; a < 2; ++a)
#pragma unroll
        for (int b = 0; b < 2; ++b)
#pragma unroll
            for (int m = 0; m < 4; ++m)
#pragma unroll
                for (int n = 0; n < 2; ++n) acc[a][b][m][n] = (f32x4){0.f, 0.f, 0.f, 0.f};
    bf16x8 At[4][2], B0[2][2], B1[2][2];
    const char* cA = (const char*)g.A + (size_t)cur.pm * tstepA; const char* cB = (const char*)g.Bt + (size_t)cur.pn * tstep;
    S.a_ready(cur);
    if constexpr (SP2) {
        PG8_STAGE(PG8_SB(0, 0), cB, voffB); PG8_STAGE(PG8_SB(0, 1), cB + hstep, voffB); PG8_STAGE(PG8_SA(0, 0), cA, voffA); PG8_STAGE(PG8_SA(0, 1), cA + hstepA, voffA);
        if (wr == 1) PG8_BAR;
        PG8_WAIT_V(2); PG8_BAR;
        PG8_STAGE(PG8_SB(1, 0), cB + kstep, voffB); PG8_STAGE(PG8_SA(1, 0), cA + kstep, voffA); PG8_STAGE(PG8_SB(1, 1), cB + hstep + kstep, voffB);
        PG8_WAIT_V(6); PG8_BAR;
    } else {
        PG8_STAGE(PG8_SB(0, 0), cB, voffB); PG8_STAGE(PG8_SA(0, 0), cA, voffA); PG8_STAGE(PG8_SB(0, 1), cB + hstep, voffB); PG8_STAGE(PG8_SA(0, 1), cA + hstepA, voffA);
        if (wr == 1) PG8_BAR;
        PG8_WAIT_V(4); PG8_BAR;
        PG8_STAGE(PG8_SB(1, 0), cB + kstep, voffB); PG8_STAGE(PG8_SA(1, 0), cA + kstep, voffA); PG8_STAGE(PG8_SB(1, 1), cB + hstep + kstep, voffB);
        PG8_WAIT_V(6); PG8_BAR;
    }
    for (;;) {
        const bool has_next = S.next(ui + 1, nxt);
        const char* nA = has_next ? (const char*)g.A + (size_t)nxt.pm * tstepA : cA; const char* nB = has_next ? (const char*)g.Bt + (size_t)nxt.pn * tstep : cB;
        for (int t = 0; t < nt; t += 2) {
            const bool last = (t == nt - 2);
            const char* a1 = cA + (size_t)(t + 1) * kstep;
            const char* a2 = last ? nA : cA + (size_t)(t + 2) * kstep; const char* b2 = last ? nB : cB + (size_t)(t + 2) * kstep;
            const char* a3 = a2 + kstep; const char* b3 = b2 + kstep;
            if (last && has_next) S.a_ready(nxt);
            if constexpr (SP2) {
            PG8_LDB(B0, 0, 0); PG8_LDB(B1, 0, 1); PG8_SCHED; PG8_LDA(At, 0, 0); PG8_STAGE(PG8_SA(1, 1), a1 + hstepA, voffA);
            PG8_WAIT_V(8); PG8_WAIT_L(0); PG8_BAR; PG8_MMA(0, 0, At, B0); PG8_MMA(0, 1, At, B1); PG8_BAR; PG8_SCHED;
            PG8_LDA(At, 0, 1); PG8_STAGE(PG8_SB(0, 0), b2, voffB); PG8_STAGE(PG8_SB(0, 1), b2 + hstep, voffB); PG8_STAGE(PG8_SA(0, 0), a2, voffA);
            PG8_WAIT_V(8); PG8_WAIT_L(0); PG8_BAR; PG8_MMA(1, 0, At, B0); PG8_MMA(1, 1, At, B1); PG8_BAR; PG8_SCHED;
            PG8_LDB(B0, 1, 0); PG8_LDB(B1, 1, 1); PG8_SCHED; PG8_LDA(At, 1, 0); PG8_STAGE(PG8_SA(0, 1), a2 + hstepA, voffA);
            PG8_WAIT_V(8); PG8_WAIT_L(0); PG8_BAR; PG8_MMA(0, 0, At, B0); PG8_MMA(0, 1, At, B1); PG8_BAR; PG8_SCHED;
            PG8_LDA(At, 1, 1); PG8_STAGE(PG8_SB(1, 0), b3, voffB); PG8_STAGE(PG8_SB(1, 1), b3 + hstep, voffB); PG8_STAGE(PG8_SA(1, 0), a3, voffA);
            PG8_WAIT_V(8); PG8_WAIT_L(0); PG8_BAR; PG8_MMA(1, 0, At, B0); PG8_MMA(1, 1, At, B1); PG8_BAR; PG8_SCHED;
            } else {
            PG8_LDB(B0, 0, 0); PG8_SCHED; PG8_LDA(At, 0, 0); PG8_STAGE(PG8_SA(1, 1), a1 + hstepA, voffA);
            PG8_WAIT_L(8); PG8_BAR; PG8_WAIT_L(0); PG8_MMA(0, 0, At, B0); PG8_BAR; PG8_SCHED;
            PG8_LDB(B1, 0, 1); PG8_STAGE(PG8_SB(0, 0), b2, voffB);
            PG8_BAR; PG8_WAIT_L(0); PG8_MMA(0, 1, At, B1); PG8_BAR;
            PG8_LDA(At, 0, 1); PG8_STAGE(PG8_SA(0, 0), a2, voffA);
            PG8_BAR; PG8_WAIT_L(0); PG8_MMA(1, 0, At, B0); PG8_BAR; PG8_SCHED;
            PG8_STAGE(PG8_SB(0, 1), b2 + hstep, voffB);
            PG8_WAIT_V(6); PG8_BAR; PG8_MMA(1, 1, At, B1); PG8_BAR;
            PG8_LDB(B0, 1, 0); PG8_SCHED; PG8_LDA(At, 1, 0); PG8_STAGE(PG8_SA(0, 1), a2 + hstepA, voffA);
            PG8_WAIT_L(8); PG8_BAR; PG8_WAIT_L(0); PG8_MMA(0, 0, At, B0); PG8_BAR; PG8_SCHED;
            PG8_LDB(B1, 1, 1); PG8_STAGE(PG8_SB(1, 0), b3, voffB);
            PG8_BAR; PG8_WAIT_L(0); PG8_MMA(0, 1, At, B1); PG8_BAR;
            PG8_LDA(At, 1, 1); PG8_STAGE(PG8_SA(1, 0), a3, voffA);
            PG8_BAR; PG8_WAIT_L(0); PG8_MMA(1, 0, At, B0); PG8_BAR; PG8_SCHED;
            PG8_STAGE(PG8_SB(1, 1), b3 + hstep, voffB);
            PG8_WAIT_V(6); PG8_BAR; PG8_MMA(1, 1, At, B1); PG8_BAR;
            }
        }
        if constexpr (ALIGN_EPI) { if (wr == 0) PG8_BAR; }
        if constexpr (!Epi::AFTER_DRAIN) { E(acc, cur, wr, wc, fr, fq); S.done(cur); }
        if (!has_next) break;
#pragma unroll
        for (int a = 0; a < 2; ++a)
#pragma unroll
            for (int b = 0; b < 2; ++b)
#pragma unroll
                for (int m = 0; m < 4; ++m)
#pragma unroll
                    for (int n = 0; n < 2; ++n) acc[a][b][m][n] = (f32x4){0.f, 0.f, 0.f, 0.f};
        cur = nxt; cA = nA; cB = nB; ++ui;
        if constexpr (ALIGN_EPI) { if (wr == 1) PG8_BAR; }
    }
    PG8_WAIT_V(0);
    if constexpr (!ALIGN_EPI) { if (wr == 0) PG8_BAR; }
    PG8_BAR;
    if constexpr (Epi::AFTER_DRAIN) { E.fused(acc, cur, wr, wc, fr, fq, lds, wid, lane); S.done(cur); }
#undef PG8_SA
#undef PG8_SB
#undef PG8_STAGE
#undef PG8_LDA
#undef PG8_LDB
#undef PG8_MMA
#undef PG8_WAIT_V
#undef PG8_WAIT_L
#undef PG8_BAR
#undef PG8_SCHED
}
}

#define LAS __attribute__((address_space(3)))
typedef unsigned u32x2 __attribute__((ext_vector_type(2)));
typedef unsigned u32x4 __attribute__((ext_vector_type(4)));
typedef short s16x4 __attribute__((ext_vector_type(4)));
using pg8::bf16_t; using pg8::bf16x8; using pg8::f32x4; using pg8::cvt_pk_bf16;

constexpr int NWAVES = 8, NTHREADS = 512;
constexpr int BSZ = 8, SEQ = 2048, DM = 1024, MTOK = BSZ * SEQ;
constexpr int M1 = MTOK + 256;
constexpr int NPA = 6144, NPB = 2048, N1 = 8448, DFF = 2816, INW = 8216;
constexpr float EPS = 1e-6f;
constexpr int C_Q = 0, C_K = 512, C_V = 1024, C_O = 2048, C_Z = 3072, C_X = 4096;
constexpr int C_MERGED = 4096, C_H1B = 5120, C_ACT = 0;
constexpr size_t OFF_PA = 0;
constexpr size_t OFF_U = OFF_PA + (size_t)M1 * NPA * 2;
constexpr size_t OFF_WIN = OFF_U + (size_t)M1 * DM * 2;
constexpr size_t OFF_GATES = OFF_WIN + (size_t)N1 * DM * 2;
constexpr size_t OFF_SSQ = OFF_GATES + (size_t)M1 * 32 * 4;
constexpr size_t OFF_SSQ2 = OFF_SSQ + (size_t)MTOK * 32 * 4;
constexpr size_t OFF_SSQ3 = OFF_SSQ2 + (size_t)MTOK * 16 * 4;
constexpr size_t WS_END = OFF_SSQ3 + (size_t)MTOK * 16 * 4;
constexpr size_t OFF_WM = OFF_U, OFF_WS = OFF_WM + (size_t)DM * DM * 2, OFF_WO = OFF_WS + (size_t)DM * DM * 2;
constexpr size_t OFF_WFI = OFF_WO + (size_t)DM * DM * 2, OFF_WFO = OFF_WFI + (size_t)2 * DFF * DM * 2;
static_assert(OFF_WFO + (size_t)DM * DFF * 2 <= OFF_WIN, "late weight copies fit the U region");
static_assert(WS_END <= 268435456ull, "workspace map");
constexpr int LDS_BYTES = 147456;

__device__ __forceinline__ float bf_lo(unsigned u) { return __uint_as_float(u << 16); }
__device__ __forceinline__ float bf_hi(unsigned u) { return __uint_as_float(u & 0xffff0000u); }
__device__ __forceinline__ float bf1(bf16_t h) { return __uint_as_float((unsigned)h << 16); }
__device__ __forceinline__ bf16_t f2bf(float f) { return (bf16_t)(cvt_pk_bf16(f, 0.f) & 0xffffu); }
__device__ __forceinline__ float sigmoid_(float x) { return 1.f / (1.f + __expf(-x)); }
__device__ __forceinline__ float silu_(float x) { return x / (1.f + __expf(-x)); }
__device__ __forceinline__ float softplus_(float x) { return fmaxf(x, 0.f) + log1pf(__expf(-fabsf(x))); }
__device__ __forceinline__ float wave_sum(float v) {
#pragma unroll
    for (int o = 1; o < 64; o <<= 1) v += __shfl_xor(v, o);
    return v;
}
__device__ __forceinline__ void unpack8(const u32x4 u, float (&f)[8]) {
    f[0] = bf_lo(u.x); f[1] = bf_hi(u.x); f[2] = bf_lo(u.y); f[3] = bf_hi(u.y); f[4] = bf_lo(u.z); f[5] = bf_hi(u.z); f[6] = bf_lo(u.w); f[7] = bf_hi(u.w);
}
__device__ __forceinline__ u32x4 pack8(const float (&f)[8]) {
    u32x4 u; u.x = cvt_pk_bf16(f[0], f[1]); u.y = cvt_pk_bf16(f[2], f[3]); u.z = cvt_pk_bf16(f[4], f[5]); u.w = cvt_pk_bf16(f[6], f[7]); return u;
}
#define LDS_WAIT() asm volatile("s_waitcnt lgkmcnt(0)" ::: "memory")

struct Args { const float* in[20]; float* out; unsigned char* ws; };
enum { I_X = 0, I_META, I_N1G, I_WIN, I_IGB, I_FGB, I_MNG, I_MPROJ, I_CONVW, I_CONVB, I_DTB, I_ALOG, I_SD, I_SNG, I_SPROJ, I_WOUT, I_N2G, I_WFI, I_WFO, I_NFG };

struct EpiProj {
    static constexpr bool PERM = true, AFTER_DRAIN = false;
    bf16_t* PA; bf16_t* PB; float* GATES;
    __device__ __forceinline__ void operator()(const f32x4 (&acc)[2][2][4][2], const pg8::Unit& u, int wr, int wc, int fr, int fq) const {
        const int row0 = u.pm * 256 + wr * 64 + fr;
        if (u.pn == 32) {
            if (wc == 0) {
#pragma unroll
                for (int ai = 0; ai < 2; ++ai)
#pragma unroll
                    for (int m = 0; m < 4; ++m) { float* gp = GATES + (size_t)(row0 + ai * 128 + m * 16) * 32 + 8 * fq; *(f32x4*)gp = acc[ai][0][m][0]; *(f32x4*)(gp + 4) = acc[ai][0][m][1]; }
            }
            return;
        }
        bf16_t* base; int ld;
        if (u.pn < 24) { base = PA + 256 * u.pn; ld = NPA; }
        else { if (u.pm >= 64) return; base = PB + 256 * (u.pn - 24); ld = NPB; }
        const int col0 = wc * 32 + 8 * fq;
#pragma unroll
        for (int ai = 0; ai < 2; ++ai)
#pragma unroll
            for (int m = 0; m < 4; ++m) { bf16_t* rowp = base + (size_t)(row0 + ai * 128 + m * 16) * ld + col0;
#pragma unroll
                for (int bj = 0; bj < 2; ++bj) { const f32x4 v0 = acc[ai][bj][m][0], v1 = acc[ai][bj][m][1];
                    u32x4 w; w.x = cvt_pk_bf16(v0[0], v0[1]); w.y = cvt_pk_bf16(v0[2], v0[3]); w.z = cvt_pk_bf16(v1[0], v1[1]); w.w = cvt_pk_bf16(v1[2], v1[3]);
                    *(u32x4*)(rowp + bj * 128) = w; } }
    }
};
struct EpiBranchA {
    static constexpr bool PERM = false, AFTER_DRAIN = false;
    float* TA; const bf16_t* PB;
    __device__ __forceinline__ void operator()(const f32x4 (&acc)[2][2][4][2], const pg8::Unit& u, int wr, int wc, int fr, int fq) const {
        const int col0 = u.pn * 256 + wc * 32 + 4 * fq;
#pragma unroll
        for (int ai = 0; ai < 2; ++ai)
#pragma unroll
            for (int m = 0; m < 4; ++m) { const size_t row = (size_t)(u.pm * 256 + ai * 128 + wr * 64 + m * 16 + fr);
#pragma unroll
                for (int bj = 0; bj < 2; ++bj)
#pragma unroll
                    for (int n = 0; n < 2; ++n) { const int col = col0 + bj * 128 + n * 16;
                        const u32x2 g = *(const u32x2*)(PB + row * NPB + col); const f32x4 a = acc[ai][bj][m][n];
                        f32x4 o; o[0] = sigmoid_(bf_lo(g.x)) * a[0]; o[1] = sigmoid_(bf_hi(g.x)) * a[1]; o[2] = sigmoid_(bf_lo(g.y)) * a[2]; o[3] = sigmoid_(bf_hi(g.y)) * a[3];
                        *(f32x4*)(TA + row * 3072 + col) = o; } }
    }
};
struct EpiBranchB {
    static constexpr bool PERM = false, AFTER_DRAIN = false;
    const float* TA; const bf16_t* PB; bf16_t* PA;
    __device__ __forceinline__ void operator()(const f32x4 (&acc)[2][2][4][2], const pg8::Unit& u, int wr, int wc, int fr, int fq) const {
        const int col0 = u.pn * 256 + wc * 32 + 4 * fq;
#pragma unroll
        for (int ai = 0; ai < 2; ++ai)
#pragma unroll
            for (int m = 0; m < 4; ++m) { const size_t row = (size_t)(u.pm * 256 + ai * 128 + wr * 64 + m * 16 + fr);
#pragma unroll
                for (int bj = 0; bj < 2; ++bj)
#pragma unroll
                    for (int n = 0; n < 2; ++n) { const int col = col0 + bj * 128 + n * 16;
                        const u32x2 g = *(const u32x2*)(PB + row * NPB + 1024 + col); const f32x4 a = acc[ai][bj][m][n]; const f32x4 t = *(const f32x4*)(TA + row * 3072 + col);
                        const float o0 = t[0] + sigmoid_(bf_lo(g.x)) * a[0], o1 = t[1] + sigmoid_(bf_hi(g.x)) * a[1], o2 = t[2] + sigmoid_(bf_lo(g.y)) * a[2], o3 = t[3] + sigmoid_(bf_hi(g.y)) * a[3];
                        u32x2 w; w.x = cvt_pk_bf16(o0, o1); w.y = cvt_pk_bf16(o2, o3);
                        *(u32x2*)(PA + row * NPA + C_MERGED + col) = w; } }
    }
};
struct EpiOut {
    static constexpr bool PERM = false, AFTER_DRAIN = false;
    const float* X; float* H1; bf16_t* PA; float* SSQ2;
    __device__ __forceinline__ void operator()(const f32x4 (&acc)[2][2][4][2], const pg8::Unit& u, int wr, int wc, int fr, int fq) const {
        const int col0 = u.pn * 256 + wc * 32 + 4 * fq;
#pragma unroll
        for (int ai = 0; ai < 2; ++ai)
#pragma unroll
            for (int m = 0; m < 4; ++m) { const size_t row = (size_t)(u.pm * 256 + ai * 128 + wr * 64 + m * 16 + fr); float s = 0.f;
#pragma unroll
                for (int bj = 0; bj < 2; ++bj)
#pragma unroll
                    for (int n = 0; n < 2; ++n) { const int col = col0 + bj * 128 + n * 16;
                        const f32x4 hv = *(const f32x4*)(X + row * DM + col) + acc[ai][bj][m][n];
                        *(f32x4*)(H1 + row * DM + col) = hv; s += (hv[0] * hv[0] + hv[1] * hv[1]) + (hv[2] * hv[2] + hv[3] * hv[3]);
                        u32x2 w; w.x = cvt_pk_bf16(hv[0], hv[1]); w.y = cvt_pk_bf16(hv[2], hv[3]);
                        *(u32x2*)(PA + row * NPA + C_H1B + col) = w; }
                s += __shfl_xor(s, 16); s += __shfl_xor(s, 32);
                if (fq == 0) SSQ2[row * 16 + u.pn * 4 + wc] = s; }
    }
};
struct EpiFfnIn {
    static constexpr bool PERM = true, AFTER_DRAIN = false;
    const float* SSQ2; bf16_t* PA;
    __device__ __forceinline__ void operator()(const f32x4 (&acc)[2][2][4][2], const pg8::Unit& u, int wr, int wc, int fr, int fq) const {
        const int col0 = C_ACT + u.pn * 128 + wc * 32 + 8 * fq;
#pragma unroll
        for (int ai = 0; ai < 2; ++ai)
#pragma unroll
            for (int m = 0; m < 4; ++m) { const size_t row = (size_t)(u.pm * 256 + wr * 64 + fr + ai * 128 + m * 16);
                const f32x4* sp = (const f32x4*)(SSQ2 + row * 16); const f32x4 s0 = sp[0], s1 = sp[1], s2 = sp[2], s3 = sp[3];
                const float ss = ((s0[0] + s0[1]) + (s0[2] + s0[3])) + ((s1[0] + s1[1]) + (s1[2] + s1[3])) + ((s2[0] + s2[1]) + (s2[2] + s2[3])) + ((s3[0] + s3[1]) + (s3[2] + s3[3]));
                const float r = 1.0f / sqrtf(ss * (1.0f / DM) + EPS);
                float o[8];
#pragma unroll
                for (int n = 0; n < 2; ++n)
#pragma unroll
                    for (int j = 0; j < 4; ++j) { const float g = r * acc[ai][0][m][n][j], up = r * acc[ai][1][m][n][j]; o[4 * n + j] = silu_(g) * up; }
                *(u32x4*)(PA + row * NPA + col0) = pack8(o); }
    }
};
struct EpiFfnOut {
    static constexpr bool PERM = false, AFTER_DRAIN = false;
    float* H; float* SSQ3;
    __device__ __forceinline__ void operator()(const f32x4 (&acc)[2][2][4][2], const pg8::Unit& u, int wr, int wc, int fr, int fq) const {
        const int col0 = u.pn * 256 + wc * 32 + 4 * fq;
#pragma unroll
        for (int ai = 0; ai < 2; ++ai)
#pragma unroll
            for (int m = 0; m < 4; ++m) { const size_t row = (size_t)(u.pm * 256 + ai * 128 + wr * 64 + m * 16 + fr); float s = 0.f;
#pragma unroll
                for (int bj = 0; bj < 2; ++bj)
#pragma unroll
                    for (int n = 0; n < 2; ++n) { const int col = col0 + bj * 128 + n * 16;
                        const f32x4 hv = *(const f32x4*)(H + row * DM + col) + acc[ai][bj][m][n];
                        *(f32x4*)(H + row * DM + col) = hv; s += (hv[0] * hv[0] + hv[1] * hv[1]) + (hv[2] * hv[2] + hv[3] * hv[3]); }
                s += __shfl_xor(s, 16); s += __shfl_xor(s, 32);
                if (fq == 0) SSQ3[row * 16 + u.pn * 4 + wc] = s; }
    }
};

__device__ __forceinline__ int src_col(int mode, int n) {
    if (mode == 0) return n;
    if (mode == 1) {
        if (n < 3072) return n;
        if (n < 6144) return n + 8;
        if (n < 8192) return n + 24;
        if (n < 8200) return 3072 + (n - 8192);
        if (n < 8216) return 6152 + (n - 8200);
        return -1;
    }
    const int p = n >> 8, r = n & 255;
    return r < 128 ? 128 * p + r : DFF + 128 * p + (r - 128);
}
__device__ __forceinline__ void transpose_item(const float* W, int ldw, int K, bf16_t* WT, int mode, const float* kscale, LAS float* scr, int item, int nblk, int lane) {
    const int kb = item / nblk, nb = item - kb * nblk, k0 = 64 * kb, n0 = 32 * nb;
    const int sc = src_col(mode, n0 + (lane & 31));
#pragma unroll 8
    for (int i = 0; i < 32; ++i) { const int kk = 2 * i + (lane >> 5); float v = sc >= 0 ? W[(size_t)(k0 + kk) * ldw + sc] : 0.f; if (kscale) v *= kscale[k0 + kk]; scr[kk * 33 + (lane & 31)] = v; }
    LDS_WAIT();
    const int c = lane & 7;
#pragma unroll
    for (int j = 0; j < 4; ++j) { const int n = (lane >> 3) + 8 * j; const LAS float* s = scr + (8 * c) * 33 + n;
        u32x4 o; o.x = cvt_pk_bf16(s[0 * 33], s[1 * 33]); o.y = cvt_pk_bf16(s[2 * 33], s[3 * 33]); o.z = cvt_pk_bf16(s[4 * 33], s[5 * 33]); o.w = cvt_pk_bf16(s[6 * 33], s[7 * 33]);
        *(u32x4*)(WT + (size_t)(n0 + n) * K + k0 + 8 * c) = o; }
    LDS_WAIT();
}
__device__ __forceinline__ void rms_row_to_bf16(const float* xrow, const float* g, bf16_t* orow, int lane) {
    f32x4 v[4]; float s = 0.f;
#pragma unroll
    for (int j = 0; j < 4; ++j) { v[j] = *(const f32x4*)(xrow + 4 * lane + 256 * j); s += (v[j][0] * v[j][0] + v[j][1] * v[j][1]) + (v[j][2] * v[j][2] + v[j][3] * v[j][3]); }
    const float rstd = 1.0f / sqrtf(wave_sum(s) * (1.0f / DM) + EPS);
#pragma unroll
    for (int j = 0; j < 4; ++j) { const f32x4 gg = *(const f32x4*)(g + 4 * lane + 256 * j); const f32x4 o = v[j] * rstd * gg;
        u32x2 w; w.x = cvt_pk_bf16(o[0], o[1]); w.y = cvt_pk_bf16(o[2], o[3]); *(u32x2*)(orow + 4 * lane + 256 * j) = w; }
}

namespace mx {
constexpr int KP = 136, VP = 88;
constexpr int OFF_KS = 0, OFF_PS = 34816, OFF_ST = 69632, OFF_VS = 91392, OFF_VW = 113920, OFF_VEC = 136448;
constexpr int V_RT = 0, V_CS = 128, V_ET = 256, V_WS = 384, V_EMT = 512, V_SC = 640;
constexpr float L2E = 1.4426950408889634f;
static_assert(OFF_VEC + 4 * 704 <= LDS_BYTES, "mixer LDS");

__device__ __forceinline__ const bf16_t* rowp(const bf16_t* PA, int b, int c, int p) {
    if (p < 0) { c -= 1; p += 128; }
    if (c < 0) return nullptr;
    if (c == 0) { if (p < 112) return nullptr; return PA + (size_t)(MTOK + p - 112) * NPA; }
    return PA + (size_t)(b * SEQ + (c - 1) * 128 + p) * NPA;
}
template <int OFF> __device__ __forceinline__ bf16x8 tr_frag(unsigned addr) {
    s16x4 lo, hi;
    asm volatile("ds_read_b64_tr_b16 %0, %2\n\tds_read_b64_tr_b16 %1, %2 offset:%3\n\ts_waitcnt lgkmcnt(0)" : "=&v"(lo), "=&v"(hi) : "v"(addr), "i"(OFF) : "memory");
    bf16x8 r; r[0] = lo[0]; r[1] = lo[1]; r[2] = lo[2]; r[3] = lo[3]; r[4] = hi[0]; r[5] = hi[1]; r[6] = hi[2]; r[7] = hi[3]; return r;
}
__device__ __forceinline__ void ld8_plain(const bf16_t* rp, int col, float (&f)[8]) {
    if (rp) { unpack8(*(const u32x4*)(rp + col), f); }
    else {
#pragma unroll
        for (int i = 0; i < 8; ++i) f[i] = 0.f; }
}
__device__ __forceinline__ void ld8_conv(const bf16_t* PA, int b, int c, int p, int cc, const float* cw, const float* cb, float (&f)[8]) {
    const f32x4 b0 = *(const f32x4*)(cb + cc), b1 = *(const f32x4*)(cb + cc + 4);
    float a[8] = {b0[0], b0[1], b0[2], b0[3], b1[0], b1[1], b1[2], b1[3]};
#pragma unroll
    for (int j = 0; j < 4; ++j) {
        const bf16_t* rp = rowp(PA, b, c, p - 3 + j);
        if (rp) { float x[8]; unpack8(*(const u32x4*)(rp + C_X + cc), x);
            const f32x4 w0 = *(const f32x4*)(cw + j * 2048 + cc), w1 = *(const f32x4*)(cw + j * 2048 + cc + 4);
            a[0] += x[0] * w0[0]; a[1] += x[1] * w0[1]; a[2] += x[2] * w0[2]; a[3] += x[3] * w0[3];
            a[4] += x[4] * w1[0]; a[5] += x[5] * w1[1]; a[6] += x[6] * w1[2]; a[7] += x[7] * w1[3]; }
    }
#pragma unroll
    for (int i = 0; i < 8; ++i) f[i] = silu_(a[i]);
}
__device__ __forceinline__ f32x4 mfma16(bf16x8 a, bf16x8 b, f32x4 c) { return __builtin_amdgcn_mfma_f32_16x16x32_bf16(a, b, c, 0, 0, 0); }

struct MixArgs { bf16_t* PA; const float* GATES; float* SSQ; const float *igb, *fgb, *mng, *convw, *convb, *dtb, *alog, *sd, *sng; };

template <bool ML>
__device__ __forceinline__ void mixer_item(LAS unsigned char* L, const MixArgs& A, int item) {
    const int tid = threadIdx.x, lane = tid & 63, w = __builtin_amdgcn_readfirstlane(tid >> 6), fr = lane & 15, fq = lane >> 4;
    const int b = item >> 4;
    int h = 0, sl = 0, head = 0, g = 0;
    if (ML) { h = (item >> 2) & 3; sl = item & 3; } else { head = item & 15; g = head >> 2; }
    const int qcol = ML ? C_Q + 128 * h : C_X + 1536 + 128 * g;
    const int kcol = ML ? C_K + 128 * h : C_X + 1024 + 128 * g;
    const int vcol = ML ? C_V + 256 * h + 64 * sl : C_X + 64 * head;
    const int ocol = ML ? C_O + 256 * h + 64 * sl : C_Z + 64 * head;
    const int gi = ML ? h : 4 + g, part = ML ? sl : (head & 3);
    constexpr int NTL = ML ? 5 : 4;
    const float qscale = ML ? 0.08838834764831845f : 1.0f;
    bf16_t* PA = A.PA;
    LAS bf16_t* Ks = (LAS bf16_t*)(L + OFF_KS); LAS bf16_t* Ps = (LAS bf16_t*)(L + OFF_PS); LAS bf16_t* St = (LAS bf16_t*)(L + OFF_ST);
    LAS bf16_t* Vs = (LAS bf16_t*)(L + OFF_VS); LAS bf16_t* Vw = (LAS bf16_t*)(L + OFF_VW); LAS float* vec = (LAS float*)(L + OFF_VEC);
    const unsigned lbase = (unsigned)(uintptr_t)L;
    const int q4 = fr >> 2, p4 = fr & 3, t0 = 16 * w;
    const unsigned vs_tr = lbase + OFF_VS + (8 * fq + q4) * (VP * 2) + 8 * p4;
    const unsigned vw_tr = lbase + OFF_VW + (8 * fq + q4) * (VP * 2) + 8 * p4;
    const unsigned ks_tr = lbase + OFF_KS + (8 * fq + q4) * (KP * 2) + (16 * w + 4 * p4) * 2;

    for (int i = tid; i < 80 * KP * 2 / 16; i += NTHREADS) ((LAS u32x4*)St)[i] = (u32x4){0u, 0u, 0u, 0u};
    if (tid == 0) { vec[V_SC] = 0.f; vec[V_SC + 1] = 0.f; }
    f32x4 sacc[NTL];
#pragma unroll
    for (int n = 0; n < NTL; ++n) sacc[n] = (f32x4){0.f, 0.f, 0.f, 0.f};
    float ib = 0.f, fb = 0.f, dtb = 0.f, Aneg = 0.f, Dh = 0.f;
    if (ML) { ib = A.igb[h]; fb = A.fgb[h]; } else { dtb = A.dtb[head]; Aneg = -__expf(A.alog[head]); Dh = A.sd[head]; }
    __syncthreads();

    for (int c = 0; c < 17; ++c) {
        if (w == 0) {
            const float m_prev = vec[V_SC];
            float gl[2], il[2];
#pragma unroll
            for (int e = 0; e < 2; ++e) {
                const int p = 2 * lane + e; const bool valid = (c > 0) || (p >= 112);
                const size_t grow = (c == 0) ? (size_t)(MTOK + (valid ? p - 112 : 0)) : (size_t)(b * SEQ + (c - 1) * 128 + p);
                if (ML) {
                    const float ip = A.GATES[grow * 32 + h] + ib, fp = A.GATES[grow * 32 + 4 + h] + fb;
                    const float ic = 15.f * tanhf(ip * (1.f / 15.f)), fc = 15.f * tanhf(fp * (1.f / 15.f));
                    il[e] = valid ? ic : -INFINITY; gl[e] = valid ? -softplus_(-fc) : 0.f;
                } else {
                    const float dt = valid ? softplus_(A.GATES[grow * 32 + 8 + head] + dtb) : 0.f;
                    gl[e] = Aneg * dt; il[e] = dt > 0.f ? __logf(dt) : -INFINITY;
                }
            }
            const float s1 = gl[0] + gl[1]; float incl = s1;
#pragma unroll
            for (int o = 1; o < 64; o <<= 1) { const float v = __shfl_up(incl, o); if (lane >= o) incl += v; }
            const float excl = incl - s1, bb0 = excl + gl[0], bb1 = incl, bL = __shfl(incl, 63);
            const float a0 = il[0] - bb0, a1 = il[1] - bb1;
            if (ML) {
                float im = fmaxf(a0, a1);
#pragma unroll
                for (int o = 1; o < 64; o <<= 1) { const float v = __shfl_up(im, o); if (lane >= o) im = fmaxf(im, v); }
                float em = __shfl_up(im, 1); if (lane == 0) em = -INFINITY;
                const float M0 = fmaxf(m_prev, fmaxf(em, a0)), M1v = fmaxf(m_prev, im), Ml = __shfl(M1v, 63);
                vec[V_RT + 2 * lane] = -M0 * L2E; vec[V_RT + 2 * lane + 1] = -M1v * L2E;
                vec[V_CS + 2 * lane] = a0 * L2E; vec[V_CS + 2 * lane + 1] = a1 * L2E;
                vec[V_ET + 2 * lane] = __expf(m_prev - M0) * qscale; vec[V_ET + 2 * lane + 1] = __expf(m_prev - M1v) * qscale;
                vec[V_EMT + 2 * lane] = __expf(-(bb0 + M0)); vec[V_EMT + 2 * lane + 1] = __expf(-(bb1 + M1v));
                vec[V_WS + 2 * lane] = __expf(a0 - Ml); vec[V_WS + 2 * lane + 1] = __expf(a1 - Ml);
                if (lane == 0) { vec[V_SC] = bL + Ml; vec[V_SC + 1] = __expf(m_prev - Ml); }
            } else {
                vec[V_RT + 2 * lane] = bb0 * L2E; vec[V_RT + 2 * lane + 1] = bb1 * L2E;
                vec[V_CS + 2 * lane] = a0 * L2E; vec[V_CS + 2 * lane + 1] = a1 * L2E;
                vec[V_ET + 2 * lane] = __expf(bb0); vec[V_ET + 2 * lane + 1] = __expf(bb1);
                vec[V_WS + 2 * lane] = __expf(bL + a0); vec[V_WS + 2 * lane + 1] = __expf(bL + a1);
                if (lane == 0) { vec[V_SC + 1] = __expf(bL); }
            }
        }
        __syncthreads();
#pragma unroll 1
        for (int i = 0; i < 4; ++i) {
            const int id = tid + NTHREADS * i, s = id >> 4, seg = id & 15; float f[8];
            if (ML) ld8_plain(rowp(PA, b, c, s), kcol + 8 * seg, f); else ld8_conv(PA, b, c, s, kcol - C_X + 8 * seg, A.convw, A.convb, f);
            *(LAS u32x4*)(Ks + s * KP + 8 * seg) = pack8(f);
        }
#pragma unroll 1
        for (int i = 0; i < 2; ++i) {
            const int id = tid + NTHREADS * i, s = id >> 3, seg = id & 7; float f[8];
            if (ML) ld8_plain(rowp(PA, b, c, s), vcol + 8 * seg, f); else ld8_conv(PA, b, c, s, vcol - C_X + 8 * seg, A.convw, A.convb, f);
            const float wsv = vec[V_WS + s];
            *(LAS u32x4*)(Vs + s * VP + 8 * seg) = pack8(f);
#pragma unroll
            for (int k = 0; k < 8; ++k) f[k] *= wsv;
            *(LAS u32x4*)(Vw + s * VP + 8 * seg) = pack8(f);
        }
        if (ML && tid < 256) {
            const int s = tid >> 1, half = tid & 1; const float wsv = vec[V_WS + s];
            u32x4 o1 = (u32x4){0u, 0u, 0u, 0u}, o2 = o1;
            if (half == 0) { o1.x = 0x3f80u; o2.x = cvt_pk_bf16(wsv, 0.f); }
            *(LAS u32x4*)(Vs + s * VP + 64 + 8 * half) = o1; *(LAS u32x4*)(Vw + s * VP + 64 + 8 * half) = o2;
        }
        __syncthreads();
        if (c > 0) {
            bf16x8 qf[4];
#pragma unroll
            for (int ks = 0; ks < 4; ++ks) {
                if (ML) { qf[ks] = *(const bf16x8*)(rowp(PA, b, c, t0 + fr) + qcol + 32 * ks + 8 * fq); }
                else { float f[8]; ld8_conv(PA, b, c, t0 + fr, qcol - C_X + 32 * ks + 8 * fq, A.convw, A.convb, f); const u32x4 u = pack8(f); qf[ks] = __builtin_bit_cast(bf16x8, u); asm volatile("" ::: "memory"); }
            }
            const float rtv = vec[V_RT + t0 + fr]; const int t = t0 + fr;
#pragma unroll 1
            for (int i = 0; i <= w; ++i) {
                {
                    f32x4 sa = (f32x4){0.f, 0.f, 0.f, 0.f};
#pragma unroll
                    for (int ks = 0; ks < 4; ++ks) { const bf16x8 kf = *(const LAS bf16x8*)(Ks + (16 * i + fr) * KP + 32 * ks + 8 * fq); sa = mfma16(kf, qf[ks], sa); }
                    const f32x4 cs = *(const LAS f32x4*)(vec + V_CS + 16 * i + 4 * fq);
                    float pv[4];
#pragma unroll
                    for (int r = 0; r < 4; ++r) { const int s = 16 * i + 4 * fq + r; const float e = __builtin_amdgcn_exp2f(rtv + cs[r]); pv[r] = (s <= t) ? sa[r] * qscale * e : 0.f; }
                    u32x2 pw; pw.x = cvt_pk_bf16(pv[0], pv[1]); pw.y = cvt_pk_bf16(pv[2], pv[3]);
                    *(LAS u32x2*)(Ps + t * KP + 16 * i + 4 * fq) = pw;
                }
            }
            if (w < 7) *(LAS u32x2*)(Ps + t * KP + 16 * (w + 1) + 4 * fq) = (u32x2){0u, 0u};
            LDS_WAIT();
            f32x4 O[NTL];
#pragma unroll
            for (int n = 0; n < NTL; ++n) O[n] = (f32x4){0.f, 0.f, 0.f, 0.f};
#pragma unroll
            for (int ks = 0; ks < 4; ++ks) {
#pragma unroll
                for (int n = 0; n < NTL; ++n) { const bf16x8 sb = *(const LAS bf16x8*)(St + (16 * n + fr) * KP + 32 * ks + 8 * fq); O[n] = mfma16(qf[ks], sb, O[n]); }
                asm volatile("" ::: "memory");
            }
            const f32x4 etv = *(const LAS f32x4*)(vec + V_ET + t0 + 4 * fq);
#pragma unroll
            for (int n = 0; n < NTL; ++n) O[n] = O[n] * etv;
#pragma unroll 1
            for (int kk = 0; kk <= (w >> 1); ++kk) {
                {
                    const bf16x8 pa = *(const LAS bf16x8*)(Ps + (t0 + fr) * KP + 32 * kk + 8 * fq);
#pragma unroll
                    for (int n = 0; n < NTL; ++n) { const bf16x8 vb = tr_frag<4 * VP * 2>(vs_tr + kk * (32 * VP * 2) + n * 32); O[n] = mfma16(pa, vb, O[n]); }
                }
            }
            const int trow = t0 + 4 * fq; const size_t grow0 = (size_t)b * SEQ + (size_t)(c - 1) * 128 + trow;
            float inv[4] = {1.f, 1.f, 1.f, 1.f};
            if (ML) { const f32x4 em = *(const LAS f32x4*)(vec + V_EMT + trow);
#pragma unroll
                for (int r = 0; r < 4; ++r) { const float den = __shfl(O[NTL - 1][r], lane & 48); inv[r] = 1.0f / fmaxf(fabsf(den), em[r]); } }
            float ssq[4] = {0.f, 0.f, 0.f, 0.f};
#pragma unroll
            for (int n = 0; n < 4; ++n) {
                const int col = 16 * n + fr;
                const float gmul = ML ? A.mng[h * 256 + 64 * sl + col] : A.sng[64 * head + col];
#pragma unroll
                for (int r = 0; r < 4; ++r) {
                    bf16_t* addr = PA + (grow0 + r) * NPA + ocol + col; float val;
                    if (ML) { const float hraw = O[n][r] * inv[r]; ssq[r] += hraw * hraw; val = hraw * gmul * sigmoid_(bf1(*addr)); }
                    else { const float x = bf1(Vs[(trow + r) * VP + col]); const float yg = (O[n][r] + Dh * x) * silu_(bf1(*addr)); ssq[r] += yg * yg; val = yg * gmul; }
                    *addr = f2bf(val);
                }
            }
#pragma unroll
            for (int r = 0; r < 4; ++r) { float s = ssq[r]; s += __shfl_xor(s, 1); s += __shfl_xor(s, 2); s += __shfl_xor(s, 4); s += __shfl_xor(s, 8);
                if (fr == 0) A.SSQ[((grow0 + r) * 8 + gi) * 4 + part] = s; }
        }
        {
            const float adec = vec[V_SC + 1];
#pragma unroll
            for (int n = 0; n < NTL; ++n) sacc[n] = sacc[n] * adec;
#pragma unroll 1
            for (int kk = 0; kk < 4; ++kk) {
                const bf16x8 ka = tr_frag<4 * KP * 2>(ks_tr + kk * (32 * KP * 2));
#pragma unroll
                for (int n = 0; n < NTL; ++n) { const bf16x8 vb = tr_frag<4 * VP * 2>(vw_tr + kk * (32 * VP * 2) + n * 32); sacc[n] = mfma16(ka, vb, sacc[n]); }
            }
        }
        __syncthreads();
#pragma unroll
        for (int n = 0; n < NTL; ++n) { u32x2 sw; sw.x = cvt_pk_bf16(sacc[n][0], sacc[n][1]); sw.y = cvt_pk_bf16(sacc[n][2], sacc[n][3]);
            *(LAS u32x2*)(St + (16 * n + fr) * KP + 16 * w + 4 * fq) = sw; }
    }
    __syncthreads();
}
}

__global__ void __launch_bounds__(NTHREADS, 2) fwd_kernel(Args a) {
    extern __shared__ __attribute__((aligned(16))) unsigned char lds[];
    cg::grid_group grid = cg::this_grid();
    LAS unsigned char* L = (LAS unsigned char*)lds;
    const int tid = threadIdx.x, lane = tid & 63, wave = __builtin_amdgcn_readfirstlane(tid >> 6);
    const int G = gridDim.x, bx = blockIdx.x;
    const int vcu = (G % 8 == 0) ? (bx % 8) * (G / 8) + bx / 8 : bx;
    const int gw = vcu * NWAVES + wave, NGW = G * NWAVES;
    unsigned char* ws = a.ws;
    bf16_t* PA = (bf16_t*)(ws + OFF_PA); bf16_t* U = (bf16_t*)(ws + OFF_U); bf16_t* WIN = (bf16_t*)(ws + OFF_WIN);
    float* GATES = (float*)(ws + OFF_GATES); float* SSQ = (float*)(ws + OFF_SSQ); float* SSQ2 = (float*)(ws + OFF_SSQ2); float* SSQ3 = (float*)(ws + OFF_SSQ3);
    bf16_t* WM = (bf16_t*)(ws + OFF_WM); bf16_t* WSP = (bf16_t*)(ws + OFF_WS); bf16_t* WO = (bf16_t*)(ws + OFF_WO); bf16_t* WFI = (bf16_t*)(ws + OFF_WFI); bf16_t* WFO = (bf16_t*)(ws + OFF_WFO);
    bf16_t* PB = (bf16_t*)a.out; float* OUT = a.out;
    LAS float* scr = (LAS float*)(L + wave * 8448);

    for (int it = gw; it < 16 * 264; it += NGW) transpose_item(a.in[I_WIN], INW, DM, WIN, 1, nullptr, scr, it, 264, lane);
    for (int m = gw; m < M1; m += NGW) {
        if (m < MTOK) rms_row_to_bf16(a.in[I_X] + (size_t)m * DM, a.in[I_N1G], U + (size_t)m * DM, lane);
        else if (m < MTOK + 16) rms_row_to_bf16(a.in[I_META] + (size_t)(m - MTOK) * DM, a.in[I_N1G], U + (size_t)m * DM, lane);
        else { u32x4* o = (u32x4*)(U + (size_t)m * DM) + lane; o[0] = (u32x4){0u, 0u, 0u, 0u}; o[64] = (u32x4){0u, 0u, 0u, 0u}; }
    }
    grid.sync();
    {
        pg8::Gemm g{U, WIN, M1, N1, DM, DM}; pg8::StaticOrder S; S.init(M1, N1, G, bx);
        EpiProj E{PA, PB, GATES};
#ifndef NO_EpiProj
        pg8::gemm_phase<EpiProj, pg8::StaticOrder, true, true>(L, g, S, E);
#endif
    }
    grid.sync();
    {
        for (int it = gw; it < 5760; it += NGW) {
            int r = it;
            if (r < 512) { transpose_item(a.in[I_MPROJ], DM, DM, WM, 0, nullptr, scr, r, 32, lane); continue; } r -= 512;
            if (r < 512) { transpose_item(a.in[I_SPROJ], DM, DM, WSP, 0, nullptr, scr, r, 32, lane); continue; } r -= 512;
            if (r < 512) { transpose_item(a.in[I_WOUT], DM, DM, WO, 0, nullptr, scr, r, 32, lane); continue; } r -= 512;
            if (r < 2816) { transpose_item(a.in[I_WFI], 2 * DFF, DM, WFI, 2, a.in[I_N2G], scr, r, 176, lane); continue; } r -= 2816;
            transpose_item(a.in[I_WFO], DM, DFF, WFO, 0, nullptr, scr, r, 32, lane);
        }
        __syncthreads();
        mx::MixArgs MA{PA, GATES, SSQ, a.in[I_IGB], a.in[I_FGB], a.in[I_MNG], a.in[I_CONVW], a.in[I_CONVB], a.in[I_DTB], a.in[I_ALOG], a.in[I_SD], a.in[I_SNG]};
        for (int item = vcu; item < 256; item += G) {
#ifndef NO_MIXA
            if (item < 128) mx::mixer_item<true>(L, MA, item);
#endif
#ifndef NO_MIXB
            if (item >= 128) mx::mixer_item<false>(L, MA, item - 128);
#endif
        }
    }
    grid.sync();
    for (int row = gw; row < MTOK; row += NGW) {
        const int gi = lane >> 3; const f32x4 ss = *(const f32x4*)(SSQ + ((size_t)row * 8 + gi) * 4);
        const float rstd = 1.0f / sqrtf(((ss[0] + ss[1]) + (ss[2] + ss[3])) * (1.0f / 256.f) + EPS);
        u32x4* p = (u32x4*)(PA + (size_t)row * NPA + C_O + 32 * lane);
#pragma unroll
        for (int j = 0; j < 4; ++j) { float f[8]; unpack8(p[j], f);
#pragma unroll
            for (int k = 0; k < 8; ++k) f[k] *= rstd;
            p[j] = pack8(f); }
    }
    grid.sync();
    {
        pg8::Gemm g{PA + C_O, WM, MTOK, DM, DM, NPA}; pg8::StaticOrder S; S.init(MTOK, DM, G, bx);
        EpiBranchA E{(float*)PA, PB};
#ifndef NO_EpiBranchA
        pg8::gemm_phase<EpiBranchA, pg8::StaticOrder, true, true>(L, g, S, E);
#endif
    }
    {
        pg8::Gemm g{PA + C_Z, WSP, MTOK, DM, DM, NPA}; pg8::StaticOrder S; S.init(MTOK, DM, G, bx);
        EpiBranchB E{(const float*)PA, PB, PA};
#ifndef NO_EpiBranchB
        pg8::gemm_phase<EpiBranchB, pg8::StaticOrder, true, true>(L, g, S, E);
#endif
    }
    grid.sync();
    {
        pg8::Gemm g{PA + C_MERGED, WO, MTOK, DM, DM, NPA}; pg8::StaticOrder S; S.init(MTOK, DM, G, bx);
        EpiOut E{a.in[I_X], OUT, PA, SSQ2};
#ifndef NO_EpiOut
        pg8::gemm_phase<EpiOut, pg8::StaticOrder, true, true>(L, g, S, E);
#endif
    }
    grid.sync();
    {
        pg8::Gemm g{PA + C_H1B, WFI, MTOK, 2 * DFF, DM, NPA}; pg8::StaticOrder S; S.init(MTOK, 2 * DFF, G, bx);
        EpiFfnIn E{SSQ2, PA};
#ifndef NO_EpiFfnIn
        pg8::gemm_phase<EpiFfnIn, pg8::StaticOrder, true, true>(L, g, S, E);
#endif
    }
    grid.sync();
    {
        pg8::Gemm g{PA + C_ACT, WFO, MTOK, DM, DFF, NPA}; pg8::StaticOrder S; S.init(MTOK, DM, G, bx);
        EpiFfnOut E{OUT, SSQ3};
#ifndef NO_EpiFfnOut
        pg8::gemm_phase<EpiFfnOut, pg8::StaticOrder, true, true>(L, g, S, E);
#endif
    }
    grid.sync();
    for (int row = gw; row < MTOK; row += NGW) {
        float s = lane < 16 ? SSQ3[(size_t)row * 16 + lane] : 0.f;
        s = wave_sum(s);
        const float rstd = 1.0f / sqrtf(s * (1.0f / DM) + EPS);
        float* o = OUT + (size_t)row * DM;
#pragma unroll
        for (int j = 0; j < 4; ++j) { const f32x4 gg = *(const f32x4*)(a.in[I_NFG] + 4 * lane + 256 * j); f32x4 v = *(const f32x4*)(o + 4 * lane + 256 * j); v = v * rstd * gg; *(f32x4*)(o + 4 * lane + 256 * j) = v; }
    }
}

extern "C" void kernel_launch(void* const* d_in, const int* in_sizes, int n_in, void* d_out, int out_size, void* d_ws, size_t ws_size, hipStream_t stream) {
    static int grid = 0;
    if (grid == 0) {
        if (n_in != 20 || out_size != MTOK * DM || ws_size < WS_END) { fprintf(stderr, "kernel_launch: unexpected shapes (n_in %d out %d ws %zu)\n", n_in, out_size, ws_size); grid = -1; return; }
        int dev = 0, cus = 0, per_cu = 0;
        (void)hipGetDevice(&dev); (void)hipDeviceGetAttribute(&cus, hipDeviceAttributeMultiprocessorCount, dev);
        if (hipFuncSetAttribute((const void*)fwd_kernel, hipFuncAttributeMaxDynamicSharedMemorySize, LDS_BYTES) != hipSuccess) { fprintf(stderr, "kernel_launch: hipFuncSetAttribute failed\n"); grid = -1; return; }
        if (hipOccupancyMaxActiveBlocksPerMultiprocessor(&per_cu, (const void*)fwd_kernel, NTHREADS, LDS_BYTES) != hipSuccess || per_cu < 1) { fprintf(stderr, "kernel_launch: occupancy query gave %d\n", per_cu); per_cu = 1; }
        (void)hipGetLastError();
        grid = cus * 1;
        if (grid <= 0) grid = 256;
    }
    if (grid < 0) return;
    Args a{};
    for (int i = 0; i < 20; ++i) a.in[i] = (const float*)d_in[i];
    a.out = (float*)d_out; a.ws = (unsigned char*)d_ws;
    void* args[] = {&a};
    const hipError_t e = hipLaunchCooperativeKernel((const void*)fwd_kernel, dim3(grid), dim3(NTHREADS), args, LDS_BYTES, stream);
    if (e != hipSuccess) fprintf(stderr, "kernel_launch: cooperative launch failed: %s (grid %d)\n", hipGetErrorString(e), grid);
}
```

```cpp
#include <hip/hip_runtime.h>
#include <hip/hip_cooperative_groups.h>
#include <cstdio>
#include <cstdint>
namespace cg = cooperative_groups;
namespace pg8 {
#define PG8_LAS __attribute__((address_space(3)))
typedef unsigned short bf16_t;
typedef short bf16x8 __attribute__((ext_vector_type(8)));
typedef float f32x4 __attribute__((ext_vector_type(4)));
typedef unsigned u32x4 __attribute__((ext_vector_type(4)));
constexpr int BM = 256, BK = 64, HALF = 128, HTB = HALF * BK * 2  , STAGE_BYTES = 8 * HTB, NXCD = 8, WGM = 8;

__host__ __device__ __forceinline__ int lds_byte(int r, int c) { const int st = (r >> 4) * 2 + (c >> 5), rr = r & 15, cc = c & 31, ob = rr * 64 + cc * 2; return st * 1024 + (ob ^ (((ob >> 9) & 1) << 5)); }
__host__ __device__ __forceinline__ void stage_rc(int b, int& R, int& C) { const int st = b / 1024, sb = b % 1024, swz = sb ^ (((sb >> 9) & 1) << 5); R = (st >> 1) * 16 + swz / 64; C = (st & 1) * 32 + (swz % 64) / 2; }
__host__ __device__ __forceinline__ int perm32(int rho) { const int n = rho >> 4, i = rho & 15; return 8 * (i >> 2) + 4 * n + (i & 3); }

struct Unit { int pm, pn; };
struct Gemm { const bf16_t* A; const bf16_t* Bt; int M, N, K, lda; };

struct StaticOrder {
    int nM, nN, nwg, G, c;
    __host__ __device__ void init(int M, int N, int G_, int c_) { nM = M / BM; nN = N / BM; nwg = nM * nN; G = G_; c = c_; }
    __host__ __device__ bool next(int i, Unit& u) const {
        const long L = (long)i * G + c; if (L >= nwg) return false;
        int wgid = (int)L; { const int q = nwg / NXCD, r = nwg % NXCD, xcd = wgid % NXCD, off = wgid / NXCD; wgid = (xcd < r ? xcd * (q + 1) : r * (q + 1) + (xcd - r) * q) + off; }
        const int nig = WGM * nN, gid = wgid / nig, fm = gid * WGM, gsz = (nM - fm) < WGM ? (nM - fm) : WGM;
        u.pm = fm + ((wgid % nig) % gsz); u.pn = (wgid % nig) / gsz; return true;
    }
    __device__ __forceinline__ void a_ready(const Unit&) const {}
    __device__ __forceinline__ void done(const Unit&) const {}
};

__device__ __forceinline__ unsigned cvt_pk_bf16(float lo, float hi) { unsigned r; asm volatile("v_cvt_pk_bf16_f32 %0, %1, %2" : "=v"(r) : "v"(lo), "v"(hi)); return r; }
struct NoHook { static constexpr bool ENABLED = false; };
template <class Epi, class Sched, bool ALIGN_EPI = false, bool SP2 = false, class Hook = NoHook>
__device__ __forceinline__ void gemm_phase(PG8_LAS unsigned char* lds, const Gemm g, const Sched& S, const Epi& E, const int wave_u, const Hook& H = Hook()) {
    int tid_ = threadIdx.x; asm volatile("" : "+v"(tid_));
    const int tid = tid_, wid = __builtin_amdgcn_readfirstlane(tid >> 6), lane = tid & 63, wr = wid >> 2, wc = wid & 3, fr = lane & 15, fq = lane >> 4;
    const int K = g.K, nt = K / BK;
    unsigned voffA, voffB;
    { int R, C; stage_rc(tid * 16, R, C); const int Rb = Epi::PERM ? ((R & ~31) + perm32(R & 31)) : R;
        voffA = (unsigned)(R * g.lda + C) * 2u; voffB = (unsigned)(Rb * K + C) * 2u; }
    const size_t vstepA = (size_t)64 * g.lda * 2, vstepB = (size_t)64 * K * 2;
    const size_t kstep = (size_t)(BK * 2);
    const size_t hstep = (size_t)HALF * K * 2; const size_t hstepA = (size_t)HALF * g.lda * 2;
    const size_t tstep = 2 * hstep; const size_t tstepA = 2 * hstepA;
    const unsigned ldsw = (unsigned)wid * 1024u;
    const int aoff = lds_byte(wr * 64 + fr, fq * 8), boff = lds_byte(wc * 32 + fr, fq * 8);
#define PG8_SA(b, h) (((b) * 2 + (h)) * HTB)
#define PG8_SB(b, h) ((4 + (b) * 2 + (h)) * HTB)
#define PG8_STAGE(bufoff, gbase, ab) do { _Pragma("unroll") for (int _i = 0; _i < 2; ++_i) \
        __builtin_amdgcn_global_load_lds((const unsigned*)((const char*)(gbase) + (size_t)_i * vstep##ab + voff##ab), (PG8_LAS unsigned*)(lds + (bufoff) + ldsw + _i * 8192), 16, 0, 0); } while (0)
#define PG8_LDA(dst, b, h) do { _Pragma("unroll") for (int m = 0; m < 4; ++m) _Pragma("unroll") for (int k = 0; k < 2; ++k) dst[m][k] = *(const PG8_LAS bf16x8*)(lds + PG8_SA(b, h) + aoff + m * 2048 + k * 1024); } while (0)
#define PG8_LDB(dst, b, h) do { _Pragma("unroll") for (int n = 0; n < 2; ++n) _Pragma("unroll") for (int k = 0; k < 2; ++k) dst[n][k] = *(const PG8_LAS bf16x8*)(lds + PG8_SB(b, h) + boff + n * 2048 + k * 1024); } while (0)
#define PG8_MMA(ai, bj, At, Bt) do { __builtin_amdgcn_s_setprio(1); _Pragma("unroll") for (int m = 0; m < 4; ++m) _Pragma("unroll") for (int n = 0; n < 2; ++n) _Pragma("unroll") for (int k = 0; k < 2; ++k) \
        acc[ai][bj][m][n] = __builtin_amdgcn_mfma_f32_16x16x32_bf16(Bt[n][k], At[m][k], acc[ai][bj][m][n], 0, 0, 0); __builtin_amdgcn_s_setprio(0); } while (0)
#define PG8_WAIT_V(n) asm volatile("s_waitcnt vmcnt(" #n ")" ::: "memory")
#define PG8_WAIT_L(n) asm volatile("s_waitcnt lgkmcnt(" #n ")" ::: "memory")
#define PG8_BAR __builtin_amdgcn_s_barrier()
#define PG8_SCHED __builtin_amdgcn_sched_barrier(0)
    Unit cur, nxt; int ui = 0;
    if (!S.next(0, cur)) return;
    f32x4 acc[2][2][4][2];
#pragma unroll
    for (int a = 0; a < 2; ++a)
#pragma unroll
        for (int b = 0; b < 2; ++b)
#pragma unroll
            for (int m = 0; m < 4; ++m)
#pragma unroll
                for (int n = 0; n < 2; ++n) acc[a][b][m][n] = (f32x4){0.f, 0.f, 0.f, 0.f};
    bf16x8 At[4][2], B0[2][2], B1[2][2];
    const char* cA = (const char*)g.A + (size_t)cur.pm * tstepA; const char* cB = (const char*)g.Bt + (size_t)cur.pn * tstep;
    S.a_ready(cur);
    if constexpr (SP2) {
        PG8_STAGE(PG8_SB(0, 0), cB, B); PG8_STAGE(PG8_SB(0, 1), cB + hstep, B); PG8_STAGE(PG8_SA(0, 0), cA, A); PG8_STAGE(PG8_SA(0, 1), cA + hstepA, A);
        if (wr == 1) PG8_BAR;
        PG8_WAIT_V(2); PG8_BAR;
        PG8_STAGE(PG8_SB(1, 0), cB + kstep, B); PG8_STAGE(PG8_SA(1, 0), cA + kstep, A); PG8_STAGE(PG8_SB(1, 1), cB + hstep + kstep, B);
        PG8_WAIT_V(6); PG8_BAR;
    } else {
        PG8_STAGE(PG8_SB(0, 0), cB, B); PG8_STAGE(PG8_SA(0, 0), cA, A); PG8_STAGE(PG8_SB(0, 1), cB + hstep, B); PG8_STAGE(PG8_SA(0, 1), cA + hstepA, A);
        if (wr == 1) PG8_BAR;
        PG8_WAIT_V(4); PG8_BAR;
        PG8_STAGE(PG8_SB(1, 0), cB + kstep, B); PG8_STAGE(PG8_SA(1, 0), cA + kstep, A); PG8_STAGE(PG8_SB(1, 1), cB + hstep + kstep, B);
        PG8_WAIT_V(6); PG8_BAR;
    }
    for (;;) {
        const bool has_next = S.next(ui + 1, nxt);
        const char* nA = has_next ? (const char*)g.A + (size_t)nxt.pm * tstepA : cA; const char* nB = has_next ? (const char*)g.Bt + (size_t)nxt.pn * tstep : cB;
        for (int t = 0; t < nt; t += 2) {
            const bool last = (t == nt - 2);
            const char* a1 = cA + (size_t)(t + 1) * kstep;
            const char* a2 = last ? nA : cA + (size_t)(t + 2) * kstep; const char* b2 = last ? nB : cB + (size_t)(t + 2) * kstep;
            const char* a3 = a2 + kstep; const char* b3 = b2 + kstep;
            if (last && has_next) S.a_ready(nxt);
            if constexpr (Hook::ENABLED) { if (t > 0 && (t & 3) == 0) { PG8_SCHED; asm volatile("" ::: "memory"); H.seg(t >> 2, acc, cur, wr, wc, fr, fq); asm volatile("" ::: "memory"); PG8_SCHED; } }
            if constexpr (SP2) {
            PG8_LDB(B0, 0, 0); PG8_LDB(B1, 0, 1); PG8_SCHED; PG8_LDA(At, 0, 0); PG8_STAGE(PG8_SA(1, 1), a1 + hstepA, A);
            PG8_WAIT_V(8); PG8_WAIT_L(0); PG8_BAR; PG8_MMA(0, 0, At, B0); PG8_MMA(0, 1, At, B1); PG8_BAR; PG8_SCHED;
            PG8_LDA(At, 0, 1); PG8_STAGE(PG8_SB(0, 0), b2, B); PG8_STAGE(PG8_SB(0, 1), b2 + hstep, B); PG8_STAGE(PG8_SA(0, 0), a2, A);
            PG8_WAIT_V(8); PG8_WAIT_L(0); PG8_BAR; PG8_MMA(1, 0, At, B0); PG8_MMA(1, 1, At, B1); PG8_BAR; PG8_SCHED;
            PG8_LDB(B0, 1, 0); PG8_LDB(B1, 1, 1); PG8_SCHED; PG8_LDA(At, 1, 0); PG8_STAGE(PG8_SA(0, 1), a2 + hstepA, A);
            PG8_WAIT_V(8); PG8_WAIT_L(0); PG8_BAR; PG8_MMA(0, 0, At, B0); PG8_MMA(0, 1, At, B1); PG8_BAR; PG8_SCHED;
            PG8_LDA(At, 1, 1); PG8_STAGE(PG8_SB(1, 0), b3, B); PG8_STAGE(PG8_SB(1, 1), b3 + hstep, B); PG8_STAGE(PG8_SA(1, 0), a3, A);
            PG8_WAIT_V(8); PG8_WAIT_L(0); PG8_BAR; PG8_MMA(1, 0, At, B0); PG8_MMA(1, 1, At, B1); PG8_BAR; PG8_SCHED;
            } else {
            PG8_LDB(B0, 0, 0); PG8_SCHED; PG8_LDA(At, 0, 0); PG8_STAGE(PG8_SA(1, 1), a1 + hstepA, A);
            PG8_WAIT_L(8); PG8_BAR; PG8_WAIT_L(0); PG8_MMA(0, 0, At, B0); PG8_BAR; PG8_SCHED;
            PG8_LDB(B1, 0, 1); PG8_STAGE(PG8_SB(0, 0), b2, B);
            PG8_BAR; PG8_WAIT_L(0); PG8_MMA(0, 1, At, B1); PG8_BAR;
            PG8_LDA(At, 0, 1); PG8_STAGE(PG8_SA(0, 0), a2, A);
            PG8_BAR; PG8_WAIT_L(0); PG8_MMA(1, 0, At, B0); PG8_BAR; PG8_SCHED;
            PG8_STAGE(PG8_SB(0, 1), b2 + hstep, B);
            PG8_WAIT_V(6); PG8_BAR; PG8_MMA(1, 1, At, B1); PG8_BAR;
            PG8_LDB(B0, 1, 0); PG8_SCHED; PG8_LDA(At, 1, 0); PG8_STAGE(PG8_SA(0, 1), a2 + hstepA, A);
            PG8_WAIT_L(8); PG8_BAR; PG8_WAIT_L(0); PG8_MMA(0, 0, At, B0); PG8_BAR; PG8_SCHED;
            PG8_LDB(B1, 1, 1); PG8_STAGE(PG8_SB(1, 0), b3, B);
            PG8_BAR; PG8_WAIT_L(0); PG8_MMA(0, 1, At, B1); PG8_BAR;
            PG8_LDA(At, 1, 1); PG8_STAGE(PG8_SA(1, 0), a3, A);
            PG8_BAR; PG8_WAIT_L(0); PG8_MMA(1, 0, At, B0); PG8_BAR; PG8_SCHED;
            PG8_STAGE(PG8_SB(1, 1), b3 + hstep, B);
            PG8_WAIT_V(6); PG8_BAR; PG8_MMA(1, 1, At, B1); PG8_BAR;
            }
        }
        if constexpr (ALIGN_EPI) { if (wr == 0) PG8_BAR; }
        if constexpr (!Epi::AFTER_DRAIN) { E(acc, cur, wr, wc, fr, fq); S.done(cur); }
        if (!has_next) break;
#pragma unroll
        for (int a = 0; a < 2; ++a)
#pragma unroll
            for (int b = 0; b < 2; ++b)
#pragma unroll
                for (int m = 0; m < 4; ++m)
#pragma unroll
                    for (int n = 0; n < 2; ++n) acc[a][b][m][n] = (f32x4){0.f, 0.f, 0.f, 0.f};
        cur = nxt; cA = nA; cB = nB; ++ui;
        if constexpr (ALIGN_EPI) { if (wr == 1) PG8_BAR; }
    }
    PG8_WAIT_V(0);
    if constexpr (!ALIGN_EPI) { if (wr == 0) PG8_BAR; }
    PG8_BAR;
    if constexpr (Epi::AFTER_DRAIN) { E.fused(acc, cur, wr, wc, fr, fq, lds, wid, lane); S.done(cur); }
#undef PG8_SA
#undef PG8_SB
#undef PG8_STAGE
#undef PG8_LDA
#undef PG8_LDB
#undef PG8_MMA
#undef PG8_WAIT_V
#undef PG8_WAIT_L
#undef PG8_BAR
#undef PG8_SCHED
}
}

#define LAS __attribute__((address_space(3)))
typedef unsigned u32x2 __attribute__((ext_vector_type(2)));
typedef unsigned u32x4 __attribute__((ext_vector_type(4)));
typedef short s16x4 __attribute__((ext_vector_type(4)));
using pg8::bf16_t; using pg8::bf16x8; using pg8::f32x4; using pg8::cvt_pk_bf16;

constexpr int NWAVES = 8, NTHREADS = 512;
constexpr int BSZ = 8, SEQ = 2048, DM = 1024, MTOK = BSZ * SEQ;
constexpr int M1 = MTOK + 256;
constexpr int NPA = 6144, NPB = 2048, N1 = 8448, DFF = 2816, INW = 8216;
constexpr float EPS = 1e-6f;
constexpr int C_Q = 0, C_K = 512, C_V = 1024, C_O = 2048, C_Z = 3072, C_X = 4096;
constexpr int C_MERGED = 4096, C_H1B = 5120, C_ACT = 0;
constexpr size_t OFF_PA = 0;
constexpr size_t OFF_U = OFF_PA + (size_t)M1 * NPA * 2;
constexpr size_t OFF_WIN = OFF_U + (size_t)M1 * DM * 2;
constexpr size_t OFF_GATES = OFF_WIN + (size_t)N1 * DM * 2;
constexpr size_t OFF_SSQ = OFF_GATES + (size_t)M1 * 32 * 4;
constexpr size_t OFF_SSQ2 = OFF_SSQ + (size_t)MTOK * 32 * 4;
constexpr size_t OFF_SSQ3 = OFF_SSQ2 + (size_t)MTOK * 16 * 4;
constexpr size_t WS_END = OFF_SSQ3 + (size_t)MTOK * 16 * 4;
constexpr size_t OFF_WM = OFF_U, OFF_WS = OFF_WM + (size_t)DM * DM * 2, OFF_WO = OFF_WS + (size_t)DM * DM * 2;
constexpr size_t OFF_WFI = OFF_WO + (size_t)DM * DM * 2, OFF_WFO = OFF_WFI + (size_t)2 * DFF * DM * 2;
static_assert(OFF_WFO + (size_t)DM * DFF * 2 <= OFF_WIN, "late weight copies fit the U region");
static_assert(WS_END + 65536 <= 268435456ull, "workspace map");
constexpr int LDS_BYTES = 155648;

__device__ __forceinline__ float bf_lo(unsigned u) { return __uint_as_float(u << 16); }
__device__ __forceinline__ float bf_hi(unsigned u) { return __uint_as_float(u & 0xffff0000u); }
__device__ __forceinline__ float bf1(bf16_t h) { return __uint_as_float((unsigned)h << 16); }
__device__ __forceinline__ bf16_t f2bf(float f) { return (bf16_t)(cvt_pk_bf16(f, 0.f) & 0xffffu); }
__device__ __forceinline__ float sigmoid_(float x) { return __builtin_amdgcn_rcpf(1.f + __expf(-x)); }
__device__ __forceinline__ float silu_(float x) { return x * __builtin_amdgcn_rcpf(1.f + __expf(-x)); }
__device__ __forceinline__ float softplus_(float x) { return fmaxf(x, 0.f) + log1pf(__expf(-fabsf(x))); }
__device__ __forceinline__ float wave_sum(float v) {
#pragma unroll
    for (int o = 1; o < 64; o <<= 1) v += __shfl_xor(v, o);
    return v;
}
__device__ __forceinline__ void unpack8(const u32x4 u, float (&f)[8]) {
    f[0] = bf_lo(u.x); f[1] = bf_hi(u.x); f[2] = bf_lo(u.y); f[3] = bf_hi(u.y); f[4] = bf_lo(u.z); f[5] = bf_hi(u.z); f[6] = bf_lo(u.w); f[7] = bf_hi(u.w);
}
__device__ __forceinline__ u32x4 pack8(const float (&f)[8]) {
    u32x4 u; u.x = cvt_pk_bf16(f[0], f[1]); u.y = cvt_pk_bf16(f[2], f[3]); u.z = cvt_pk_bf16(f[4], f[5]); u.w = cvt_pk_bf16(f[6], f[7]); return u;
}
#define LDS_WAIT() asm volatile("s_waitcnt lgkmcnt(0)" ::: "memory")

struct Args { const float* in[20]; float* out; unsigned char* ws; };
enum { I_X = 0, I_META, I_N1G, I_WIN, I_IGB, I_FGB, I_MNG, I_MPROJ, I_CONVW, I_CONVB, I_DTB, I_ALOG, I_SD, I_SNG, I_SPROJ, I_WOUT, I_N2G, I_WFI, I_WFO, I_NFG };

struct EpiProj {
    static constexpr bool PERM = true, AFTER_DRAIN = false;
    bf16_t* PA; bf16_t* PB; float* GATES;
    __device__ __forceinline__ void operator()(const f32x4 (&acc)[2][2][4][2], const pg8::Unit& u, int wr, int wc, int fr, int fq) const {
        const int row0 = u.pm * 256 + wr * 64 + fr;
        if (u.pn == 32) {
            if (wc == 0) {
#pragma unroll
                for (int ai = 0; ai < 2; ++ai)
#pragma unroll
                    for (int m = 0; m < 4; ++m) { float* gp = GATES + (size_t)(row0 + ai * 128 + m * 16) * 32 + 8 * fq; *(f32x4*)gp = acc[ai][0][m][0]; *(f32x4*)(gp + 4) = acc[ai][0][m][1]; }
            }
            return;
        }
        bf16_t* base; int ld;
        if (u.pn < 24) { base = PA + 256 * u.pn; ld = NPA; }
        else { if (u.pm >= 64) return; base = PB + 256 * (u.pn - 24); ld = NPB; }
        const int col0 = wc * 32 + 8 * fq;
#pragma unroll
        for (int ai = 0; ai < 2; ++ai)
#pragma unroll
            for (int m = 0; m < 4; ++m) { bf16_t* rowp = base + (size_t)(row0 + ai * 128 + m * 16) * ld + col0;
#pragma unroll
                for (int bj = 0; bj < 2; ++bj) { const f32x4 v0 = acc[ai][bj][m][0], v1 = acc[ai][bj][m][1];
                    u32x4 w; w.x = cvt_pk_bf16(v0[0], v0[1]); w.y = cvt_pk_bf16(v0[2], v0[3]); w.z = cvt_pk_bf16(v1[0], v1[1]); w.w = cvt_pk_bf16(v1[2], v1[3]);
                    *(u32x4*)(rowp + bj * 128) = w; } }
    }
};
struct HookRow {
    static constexpr bool ENABLED = true;
    const LAS float* RT; int gbase;
    __device__ __forceinline__ void seg(int g1, f32x4 (&acc)[2][2][4][2], const pg8::Unit& u, int wr, int wc, int fr, int fq) const {
        const int ln_ = (int)__builtin_amdgcn_mbcnt_hi(~0u, __builtin_amdgcn_mbcnt_lo(~0u, 0u)); fr = ln_ & 15; fq = ln_ >> 4;
#pragma unroll
        for (int ai = 0; ai < 2; ++ai)
#pragma unroll
            for (int m = 0; m < 4; ++m) { const float r = RT[(ai * 128 + wr * 64 + m * 16 + fr) * 8 + gbase + g1];
#pragma unroll
                for (int bj = 0; bj < 2; ++bj)
#pragma unroll
                    for (int n = 0; n < 2; ++n) acc[ai][bj][m][n] = acc[ai][bj][m][n] * r; }
    }
};
struct EpiBranchA {
    static constexpr bool PERM = true, AFTER_DRAIN = false;
    bf16_t* PA; const bf16_t* PB; const LAS float* RT;
    __device__ __forceinline__ void operator()(const f32x4 (&acc)[2][2][4][2], const pg8::Unit& u, int wr, int wc, int fr, int fq) const {
        const int ln_ = (int)__builtin_amdgcn_mbcnt_hi(~0u, __builtin_amdgcn_mbcnt_lo(~0u, 0u)); fr = ln_ & 15; fq = ln_ >> 4;
        const int col0 = u.pn * 256 + wc * 32 + 8 * fq;
#pragma unroll
        for (int ai = 0; ai < 2; ++ai)
#pragma unroll
            for (int m = 0; m < 4; ++m) { const size_t row = (size_t)(u.pm * 256 + ai * 128 + wr * 64 + m * 16 + fr); const float r3 = RT[(ai * 128 + wr * 64 + m * 16 + fr) * 8];
#pragma unroll
                for (int bj = 0; bj < 2; ++bj) { const int col = col0 + bj * 128;
                    float g[8]; unpack8(*(const u32x4*)(PB + row * NPB + col), g);
                    float o[8];
#pragma unroll
                    for (int j = 0; j < 8; ++j) o[j] = sigmoid_(g[j]) * (acc[ai][bj][m][j >> 2][j & 3] * r3);
                    *(u32x4*)(PA + row * NPA + col) = pack8(o); } }
    }
};
struct EpiBranchB {
    static constexpr bool PERM = true, AFTER_DRAIN = false;
    const bf16_t* PB; bf16_t* PA; const LAS float* RT;
    __device__ __forceinline__ void operator()(const f32x4 (&acc)[2][2][4][2], const pg8::Unit& u, int wr, int wc, int fr, int fq) const {
        const int ln_ = (int)__builtin_amdgcn_mbcnt_hi(~0u, __builtin_amdgcn_mbcnt_lo(~0u, 0u)); fr = ln_ & 15; fq = ln_ >> 4;
        const int col0 = u.pn * 256 + wc * 32 + 8 * fq;
#pragma unroll
        for (int ai = 0; ai < 2; ++ai)
#pragma unroll
            for (int m = 0; m < 4; ++m) { const size_t row = (size_t)(u.pm * 256 + ai * 128 + wr * 64 + m * 16 + fr); const float r7 = RT[(ai * 128 + wr * 64 + m * 16 + fr) * 8 + 4];
#pragma unroll
                for (int bj = 0; bj < 2; ++bj) { const int col = col0 + bj * 128;
                    float g[8], tt[8]; unpack8(*(const u32x4*)(PB + row * NPB + 1024 + col), g); unpack8(*(const u32x4*)(PA + row * NPA + col), tt);
                    float o[8];
#pragma unroll
                    for (int j = 0; j < 8; ++j) o[j] = tt[j] + sigmoid_(g[j]) * (acc[ai][bj][m][j >> 2][j & 3] * r7);
                    *(u32x4*)(PA + row * NPA + C_MERGED + col) = pack8(o); } }
    }
};
struct EpiOut {
    static constexpr bool PERM = true, AFTER_DRAIN = false;
    const float* X; float* H1; bf16_t* PA; float* SSQ2;
    __device__ __forceinline__ void operator()(const f32x4 (&acc)[2][2][4][2], const pg8::Unit& u, int wr, int wc, int fr, int fq) const {
        const int col0 = u.pn * 256 + wc * 32 + 8 * fq;
#pragma unroll
        for (int ai = 0; ai < 2; ++ai)
#pragma unroll
            for (int m = 0; m < 4; ++m) { const size_t row = (size_t)(u.pm * 256 + ai * 128 + wr * 64 + m * 16 + fr); float s = 0.f;
#pragma unroll
                for (int bj = 0; bj < 2; ++bj) { const int col = col0 + bj * 128;
                    const f32x4 h0 = *(const f32x4*)(X + row * DM + col) + acc[ai][bj][m][0], h1 = *(const f32x4*)(X + row * DM + col + 4) + acc[ai][bj][m][1];
                    u32x4 w; w.x = cvt_pk_bf16(h0[0], h0[1]); w.y = cvt_pk_bf16(h0[2], h0[3]); w.z = cvt_pk_bf16(h1[0], h1[1]); w.w = cvt_pk_bf16(h1[2], h1[3]);
                    float hr[8]; unpack8(w, hr);
#pragma unroll
                    for (int j = 0; j < 8; ++j) s += hr[j] * hr[j];
                    *(u32x4*)(PA + row * NPA + C_H1B + col) = w; }
                s += __shfl_xor(s, 16); s += __shfl_xor(s, 32);
                if (fq == 0) SSQ2[row * 16 + u.pn * 4 + wc] = s; }
    }
};
struct EpiFfnIn {
    static constexpr bool PERM = true, AFTER_DRAIN = false;
    const float* SSQ2; bf16_t* PA;
    __device__ __forceinline__ void operator()(const f32x4 (&acc)[2][2][4][2], const pg8::Unit& u, int wr, int wc, int fr, int fq) const {
        const int col0 = C_ACT + u.pn * 128 + wc * 32 + 8 * fq;
#pragma unroll
        for (int ai = 0; ai < 2; ++ai)
#pragma unroll
            for (int m = 0; m < 4; ++m) { const size_t row = (size_t)(u.pm * 256 + wr * 64 + fr + ai * 128 + m * 16);
                const f32x4* sp = (const f32x4*)(SSQ2 + row * 16); const f32x4 s0 = sp[0], s1 = sp[1], s2 = sp[2], s3 = sp[3];
                const float ss = ((s0[0] + s0[1]) + (s0[2] + s0[3])) + ((s1[0] + s1[1]) + (s1[2] + s1[3])) + ((s2[0] + s2[1]) + (s2[2] + s2[3])) + ((s3[0] + s3[1]) + (s3[2] + s3[3]));
                const float r = 1.0f / sqrtf(ss * (1.0f / DM) + EPS);
                float o[8];
#pragma unroll
                for (int n = 0; n < 2; ++n)
#pragma unroll
                    for (int j = 0; j < 4; ++j) { const float g = r * acc[ai][0][m][n][j], up = r * acc[ai][1][m][n][j]; o[4 * n + j] = silu_(g) * up; }
                *(u32x4*)(PA + row * NPA + col0) = pack8(o); }
    }
};
struct EpiFfnOutNorm {
    static constexpr bool PERM = true, AFTER_DRAIN = true;
    float* H; float* SSQ3; unsigned* cnt; const float* gf; const bf16_t* PA;
    __device__ __forceinline__ void fused(f32x4 (&acc)[2][2][4][2], const pg8::Unit& u, int wr, int wc, int fr, int fq, PG8_LAS unsigned char* lds, int wid, int lane) const {
        const int col0 = u.pn * 256 + wc * 32 + 8 * fq;
#pragma unroll
        for (int ai = 0; ai < 2; ++ai)
#pragma unroll
            for (int m = 0; m < 4; ++m) { const size_t row = (size_t)(u.pm * 256 + ai * 128 + wr * 64 + m * 16 + fr); float s = 0.f;
#pragma unroll
                for (int bj = 0; bj < 2; ++bj) { const int col = col0 + bj * 128;
                    float hb[8]; unpack8(*(const u32x4*)(PA + row * NPA + C_H1B + col), hb);
#pragma unroll
                    for (int n = 0; n < 2; ++n) { const f32x4 hv = (f32x4){hb[4 * n], hb[4 * n + 1], hb[4 * n + 2], hb[4 * n + 3]} + acc[ai][bj][m][n];
                        acc[ai][bj][m][n] = hv; s += (hv[0] * hv[0] + hv[1] * hv[1]) + (hv[2] * hv[2] + hv[3] * hv[3]); } }
                s += __shfl_xor(s, 16); s += __shfl_xor(s, 32);
                if (fq == 0) __hip_atomic_store(SSQ3 + row * 16 + u.pn * 4 + wc, s, __ATOMIC_RELAXED, __HIP_MEMORY_SCOPE_AGENT);
                if (m & 1) asm volatile("" ::: "memory"); }
        asm volatile("s_waitcnt vmcnt(0)" ::: "memory");
        unsigned* c = cnt + 64 * u.pm;
        if (lane == 0) __hip_atomic_fetch_add(c, 1u, __ATOMIC_RELAXED, __HIP_MEMORY_SCOPE_AGENT);
        { unsigned spins = 0;
          while ((unsigned)__builtin_amdgcn_readfirstlane(__hip_atomic_load(c, __ATOMIC_RELAXED, __HIP_MEMORY_SCOPE_AGENT)) < 32u) { __builtin_amdgcn_s_sleep(2); if (++spins > (1u << 22)) break; } }
        __builtin_amdgcn_fence(__ATOMIC_ACQUIRE, "agent");
#pragma unroll
        for (int ai = 0; ai < 2; ++ai)
#pragma unroll
            for (int m = 0; m < 4; ++m) { const size_t row = (size_t)(u.pm * 256 + ai * 128 + wr * 64 + m * 16 + fr);
                const unsigned long long* sp = (const unsigned long long*)(SSQ3 + row * 16); float ss = 0.f;
#pragma unroll
                for (int i = 0; i < 8; ++i) { const unsigned long long v = __hip_atomic_load(sp + i, __ATOMIC_RELAXED, __HIP_MEMORY_SCOPE_AGENT); ss += __uint_as_float((unsigned)v) + __uint_as_float((unsigned)(v >> 32)); }
                const float rstd = 1.0f / sqrtf(ss * (1.0f / DM) + EPS);
#pragma unroll
                for (int bj = 0; bj < 2; ++bj)
#pragma unroll
                    for (int n = 0; n < 2; ++n) { const int col = col0 + bj * 128 + 4 * n;
                        const f32x4 gg = *(const f32x4*)(gf + col);
                        *(f32x4*)(H + row * DM + col) = acc[ai][bj][m][n] * rstd * gg; }
                if (m & 1) asm volatile("" ::: "memory"); }
    }
};
struct EpiFfnOutDry {
    static constexpr bool PERM = false, AFTER_DRAIN = false;
    const float* H; float* D; float* SSQ3;
    __device__ __forceinline__ void operator()(const f32x4 (&acc)[2][2][4][2], const pg8::Unit& u, int wr, int wc, int fr, int fq) const {
        const int col0 = u.pn * 256 + wc * 32 + 4 * fq;
#pragma unroll
        for (int ai = 0; ai < 2; ++ai)
#pragma unroll
            for (int m = 0; m < 4; ++m) { const size_t row = (size_t)(u.pm * 256 + ai * 128 + wr * 64 + m * 16 + fr); float s = 0.f;
#pragma unroll
                for (int bj = 0; bj < 2; ++bj)
#pragma unroll
                    for (int n = 0; n < 2; ++n) { const int col = col0 + bj * 128 + n * 16;
                        const f32x4 hv = *(const f32x4*)(H + row * DM + col) + acc[ai][bj][m][n];
                        *(f32x4*)(D + row * 3072 + col) = hv; s += (hv[0] * hv[0] + hv[1] * hv[1]) + (hv[2] * hv[2] + hv[3] * hv[3]); }
                s += __shfl_xor(s, 16); s += __shfl_xor(s, 32);
                if (fq == 0) SSQ3[row * 16 + u.pn * 4 + wc] = s; }
    }
};
__device__ __forceinline__ int src_col(int mode, int n) {
    if (mode == 0) return n;
    if (mode == 1) {
        if (n < 3072) return n;
        if (n < 6144) return n + 8;
        if (n < 8192) return n + 24;
        if (n < 8200) return 3072 + (n - 8192);
        if (n < 8216) return 6152 + (n - 8200);
        return -1;
    }
    const int p = n >> 8, r = n & 255;
    return r < 128 ? 128 * p + r : DFF + 128 * p + (r - 128);
}
__device__ __forceinline__ void transpose_item(const float* W, int ldw, int K, bf16_t* WT, int mode, const float* kscale, LAS float* scr, int item, int nblk, int lane) {
    const int kb = item / nblk, nb = item - kb * nblk, k0 = 64 * kb, n0 = 32 * nb;
    const int nq = lane & 7, kr = lane >> 3;
    const int sc = src_col(mode, n0 + 4 * nq);
#pragma unroll
    for (int i = 0; i < 8; ++i) { const int kk = 8 * i + kr; f32x4 v = (f32x4){0.f, 0.f, 0.f, 0.f}; if (sc >= 0) v = *(const f32x4*)(W + (size_t)(k0 + kk) * ldw + sc);
        if (kscale) v = v * kscale[k0 + kk];
        LAS float* d = scr + kk * 33 + 4 * nq; d[0] = v[0]; d[1] = v[1]; d[2] = v[2]; d[3] = v[3]; }
    LDS_WAIT();
    const int c = lane & 7;
#pragma unroll
    for (int j = 0; j < 4; ++j) { const int n = (lane >> 3) + 8 * j; const LAS float* s = scr + (8 * c) * 33 + n;
        u32x4 o; o.x = cvt_pk_bf16(s[0 * 33], s[1 * 33]); o.y = cvt_pk_bf16(s[2 * 33], s[3 * 33]); o.z = cvt_pk_bf16(s[4 * 33], s[5 * 33]); o.w = cvt_pk_bf16(s[6 * 33], s[7 * 33]);
        *(u32x4*)(WT + (size_t)(n0 + n) * K + k0 + 8 * c) = o; }
    LDS_WAIT();
}
__device__ __forceinline__ void transpose_items2(const float* W, int ldw, int K, bf16_t* WT, int mode, LAS float* scr, int itemA, int itemB, int nblk, int lane) {
    const int nq = lane & 7, kr = lane >> 3, c = lane & 7;
    int k0[2], n0[2], sc[2]; f32x4 v[2][8];
#pragma unroll
    for (int q = 0; q < 2; ++q) { const int item = q ? itemB : itemA; const int kb = item / nblk, nb = item - kb * nblk; k0[q] = 64 * kb; n0[q] = 32 * nb; sc[q] = src_col(mode, n0[q] + 4 * nq);
#pragma unroll
        for (int i = 0; i < 8; ++i) { v[q][i] = (f32x4){0.f, 0.f, 0.f, 0.f}; if (sc[q] >= 0) v[q][i] = *(const f32x4*)(W + (size_t)(k0[q] + 8 * i + kr) * ldw + sc[q]); } }
#pragma unroll
    for (int q = 0; q < 2; ++q) {
#pragma unroll
        for (int i = 0; i < 8; ++i) { LAS float* d = scr + (8 * i + kr) * 33 + 4 * nq; d[0] = v[q][i][0]; d[1] = v[q][i][1]; d[2] = v[q][i][2]; d[3] = v[q][i][3]; }
        LDS_WAIT();
#pragma unroll
        for (int j = 0; j < 4; ++j) { const int n = (lane >> 3) + 8 * j; const LAS float* s = scr + (8 * c) * 33 + n;
            u32x4 o; o.x = cvt_pk_bf16(s[0 * 33], s[1 * 33]); o.y = cvt_pk_bf16(s[2 * 33], s[3 * 33]); o.z = cvt_pk_bf16(s[4 * 33], s[5 * 33]); o.w = cvt_pk_bf16(s[6 * 33], s[7 * 33]);
            *(u32x4*)(WT + (size_t)(n0[q] + n) * K + k0[q] + 8 * c) = o; }
        LDS_WAIT();
    }
}
__device__ __forceinline__ void rms_row_to_bf16(const float* xrow, const float* g, bf16_t* orow, int lane) {
    f32x4 v[4]; float s = 0.f;
#pragma unroll
    for (int j = 0; j < 4; ++j) { v[j] = *(const f32x4*)(xrow + 4 * lane + 256 * j); s += (v[j][0] * v[j][0] + v[j][1] * v[j][1]) + (v[j][2] * v[j][2] + v[j][3] * v[j][3]); }
    const float rstd = 1.0f / sqrtf(wave_sum(s) * (1.0f / DM) + EPS);
#pragma unroll
    for (int j = 0; j < 4; ++j) { const f32x4 gg = *(const f32x4*)(g + 4 * lane + 256 * j); const f32x4 o = v[j] * rstd * gg;
        u32x2 w; w.x = cvt_pk_bf16(o[0], o[1]); w.y = cvt_pk_bf16(o[2], o[3]); *(u32x2*)(orow + 4 * lane + 256 * j) = w; }
}

__device__ __forceinline__ void rms_rows2_to_bf16(const float* x0, const float* x1, const float* g, bf16_t* o0, bf16_t* o1, int lane) {
    f32x4 v[4], w[4]; float s = 0.f, q = 0.f;
#pragma unroll
    for (int j = 0; j < 4; ++j) { v[j] = *(const f32x4*)(x0 + 4 * lane + 256 * j); w[j] = *(const f32x4*)(x1 + 4 * lane + 256 * j); }
#pragma unroll
    for (int j = 0; j < 4; ++j) { s += (v[j][0] * v[j][0] + v[j][1] * v[j][1]) + (v[j][2] * v[j][2] + v[j][3] * v[j][3]); q += (w[j][0] * w[j][0] + w[j][1] * w[j][1]) + (w[j][2] * w[j][2] + w[j][3] * w[j][3]); }
    const float r0 = 1.0f / sqrtf(wave_sum(s) * (1.0f / DM) + EPS), r1 = 1.0f / sqrtf(wave_sum(q) * (1.0f / DM) + EPS);
#pragma unroll
    for (int j = 0; j < 4; ++j) { const f32x4 gg = *(const f32x4*)(g + 4 * lane + 256 * j); const f32x4 a = v[j] * r0 * gg, b = w[j] * r1 * gg;
        u32x2 pa, pb; pa.x = cvt_pk_bf16(a[0], a[1]); pa.y = cvt_pk_bf16(a[2], a[3]); pb.x = cvt_pk_bf16(b[0], b[1]); pb.y = cvt_pk_bf16(b[2], b[3]);
        *(u32x2*)(o0 + 4 * lane + 256 * j) = pa; *(u32x2*)(o1 + 4 * lane + 256 * j) = pb; }
}

namespace mx {
constexpr int KP = 136, VP = 88;
constexpr int OFF_KS = 0, OFF_PS = 34816, OFF_ST = 69632, OFF_VS = 91392, OFF_VW = 113920, OFF_VEC = 136448, VEC_FLOATS = 704, OFF_CW = OFF_VEC + 2 * VEC_FLOATS * 4;
constexpr int V_RT = 0, V_CS = 128, V_ET = 256, V_WS = 384, V_EMT = 512, V_SC = 640;
constexpr int CW_Q = 0, CW_K = 640, CW_V = 1280;
constexpr float L2E = 1.4426950408889634f;
static_assert(OFF_CW + 4 * 1600 <= LDS_BYTES - 16, "mixer LDS");

__device__ __forceinline__ const bf16_t* rowp(const bf16_t* PA, int b, int c, int p) {
    if (p < 0) { c -= 1; p += 128; }
    if (c < 0) return nullptr;
    if (c == 0) { if (p < 112) return nullptr; return PA + (size_t)(MTOK + p - 112) * NPA; }
    return PA + (size_t)(b * SEQ + (c - 1) * 128 + p) * NPA;
}
template <int OFF> __device__ __forceinline__ bf16x8 tr_frag(unsigned addr) {
    s16x4 lo, hi;
    asm volatile("ds_read_b64_tr_b16 %0, %2\n\tds_read_b64_tr_b16 %1, %2 offset:%3\n\ts_waitcnt lgkmcnt(0)" : "=&v"(lo), "=&v"(hi) : "v"(addr), "i"(OFF) : "memory");
    bf16x8 r; r[0] = lo[0]; r[1] = lo[1]; r[2] = lo[2]; r[3] = lo[3]; r[4] = hi[0]; r[5] = hi[1]; r[6] = hi[2]; r[7] = hi[3]; return r;
}
__device__ __forceinline__ bf16x8 mk8(s16x4 lo, s16x4 hi) { bf16x8 r; r[0] = lo[0]; r[1] = lo[1]; r[2] = lo[2]; r[3] = lo[3]; r[4] = hi[0]; r[5] = hi[1]; r[6] = hi[2]; r[7] = hi[3]; return r; }
template <int NT, int OFF> __device__ __forceinline__ void tr_frags(unsigned addr, bf16x8 (&f)[NT]) {
    s16x4 a0, b0, a1, b1, a2, b2, a3, b3, a4, b4;
    if constexpr (NT == 5) {
        asm volatile("ds_read_b64_tr_b16 %0, %10\n\tds_read_b64_tr_b16 %1, %10 offset:%11\n\tds_read_b64_tr_b16 %2, %10 offset:32\n\tds_read_b64_tr_b16 %3, %10 offset:%12\n\t"
                     "ds_read_b64_tr_b16 %4, %10 offset:64\n\tds_read_b64_tr_b16 %5, %10 offset:%13\n\tds_read_b64_tr_b16 %6, %10 offset:96\n\tds_read_b64_tr_b16 %7, %10 offset:%14\n\t"
                     "ds_read_b64_tr_b16 %8, %10 offset:128\n\tds_read_b64_tr_b16 %9, %10 offset:%15\n\ts_waitcnt lgkmcnt(0)"
                     : "=&v"(a0), "=&v"(b0), "=&v"(a1), "=&v"(b1), "=&v"(a2), "=&v"(b2), "=&v"(a3), "=&v"(b3), "=&v"(a4), "=&v"(b4)
                     : "v"(addr), "i"(OFF), "i"(OFF + 32), "i"(OFF + 64), "i"(OFF + 96), "i"(OFF + 128) : "memory");
        f[4] = mk8(a4, b4);
    } else {
        asm volatile("ds_read_b64_tr_b16 %0, %8\n\tds_read_b64_tr_b16 %1, %8 offset:%9\n\tds_read_b64_tr_b16 %2, %8 offset:32\n\tds_read_b64_tr_b16 %3, %8 offset:%10\n\t"
                     "ds_read_b64_tr_b16 %4, %8 offset:64\n\tds_read_b64_tr_b16 %5, %8 offset:%11\n\tds_read_b64_tr_b16 %6, %8 offset:96\n\tds_read_b64_tr_b16 %7, %8 offset:%12\n\ts_waitcnt lgkmcnt(0)"
                     : "=&v"(a0), "=&v"(b0), "=&v"(a1), "=&v"(b1), "=&v"(a2), "=&v"(b2), "=&v"(a3), "=&v"(b3)
                     : "v"(addr), "i"(OFF), "i"(OFF + 32), "i"(OFF + 64), "i"(OFF + 96) : "memory");
    }
    f[0] = mk8(a0, b0); f[1] = mk8(a1, b1); f[2] = mk8(a2, b2); f[3] = mk8(a3, b3);
}
__device__ __forceinline__ f32x4 mfma16(bf16x8 a, bf16x8 b, f32x4 c) { return __builtin_amdgcn_mfma_f32_16x16x32_bf16(a, b, c, 0, 0, 0); }

template <bool CONV, int ROWS> struct Raw { u32x4 r[ROWS + (CONV ? 3 : 0)]; };
template <bool CONV, int ROWS> __device__ __forceinline__ void issue_task(Raw<CONV, ROWS>& R, const bf16_t* PA, int b, int c, int rg, int col) {
    asm volatile("" : "+s"(c));
    const int rbase = (c == 0) ? MTOK - 112 : b * SEQ + (c - 1) * 128;
    const int hbase = (c == 1) ? MTOK + 16 : rbase;
    const int minp = (c == 0) ? 112 : -3;
    const int p0 = ROWS * rg - (CONV ? 3 : 0);
    const unsigned off0 = (unsigned)(rbase + p0) * (unsigned)(NPA * 2) + (unsigned)col * 2u, hoff0 = (unsigned)(hbase + p0) * (unsigned)(NPA * 2) + (unsigned)col * 2u;
#pragma unroll
    for (int j = 0; j < ROWS + (CONV ? 3 : 0); ++j) { const int p = p0 + j; const unsigned off = (p < 0 ? hoff0 : off0) + (unsigned)(j * NPA * 2);
        R.r[j] = (u32x4){0u, 0u, 0u, 0u}; if (p >= minp) R.r[j] = *(const u32x4*)((const char*)PA + off); }
}
template <bool CONV, int W, int ROWS, bool DUAL> __device__ __forceinline__ void stage_task(const Raw<CONV, ROWS>& R, const LAS float* cw, int col, LAS bf16_t* dst, LAS bf16_t* dst2, int pitch, int row0, const LAS float* wsv) {
#pragma unroll
    for (int h = 0; h < 2; ++h) {
        f32x4 w0, w1, w2, w3, bs;
        if constexpr (CONV) { w0 = *(const LAS f32x4*)(cw + 0 * W + col + 4 * h); w1 = *(const LAS f32x4*)(cw + 1 * W + col + 4 * h); w2 = *(const LAS f32x4*)(cw + 2 * W + col + 4 * h);
                              w3 = *(const LAS f32x4*)(cw + 3 * W + col + 4 * h); bs = *(const LAS f32x4*)(cw + 4 * W + col + 4 * h); }
        f32x4 x[ROWS + (CONV ? 3 : 0)];
#pragma unroll
        for (int j = 0; j < ROWS + (CONV ? 3 : 0); ++j) { const unsigned u0 = R.r[j][2 * h], u1 = R.r[j][2 * h + 1]; x[j] = (f32x4){bf_lo(u0), bf_hi(u0), bf_lo(u1), bf_hi(u1)}; }
#pragma unroll
        for (int i = 0; i < ROWS; ++i) {
            f32x4 v;
            if constexpr (CONV) { const f32x4 a = bs + w0 * x[i] + w1 * x[i + 1] + w2 * x[i + 2] + w3 * x[i + 3]; v = (f32x4){silu_(a[0]), silu_(a[1]), silu_(a[2]), silu_(a[3])}; }
            else v = x[i];
            u32x2 pw; pw.x = cvt_pk_bf16(v[0], v[1]); pw.y = cvt_pk_bf16(v[2], v[3]);
            *(LAS u32x2*)(dst + (row0 + i) * pitch + col + 4 * h) = pw;
            if constexpr (DUAL) { const float s = wsv[row0 + i]; u32x2 pw2; pw2.x = cvt_pk_bf16(v[0] * s, v[1] * s); pw2.y = cvt_pk_bf16(v[2] * s, v[3] * s);
                *(LAS u32x2*)(dst2 + (row0 + i) * pitch + col + 4 * h) = pw2; }
        }
        asm volatile("" ::: "memory");
    }
}

__device__ __forceinline__ void bc_conv_pass(bf16_t* PA, int b, int g, int sl, int isC, const float* convw, const float* convb, unsigned* flag, bool dry = false) {
    const int tid = threadIdx.x, rg = tid >> 2, sg = tid & 3;
    const int cc = (isC ? 1536 : 1024) + 128 * g + 32 * sl + 8 * sg;
    f32x4 w[4][2], bs[2];
#pragma unroll
    for (int h = 0; h < 2; ++h) { bs[h] = *(const f32x4*)(convb + cc + 4 * h);
#pragma unroll
        for (int j = 0; j < 4; ++j) w[j][h] = *(const f32x4*)(convw + j * 2048 + cc + 4 * h); }
    u32x4 r[7], rn[7];
#define BC_LOAD(dst, kb_) do { const int p0_ = 512 * (kb_) + 4 * rg - 3; _Pragma("unroll") for (int j = 0; j < 7; ++j) { const int p_ = p0_ + j; \
        const size_t row_ = p_ >= 0 ? (size_t)(b * SEQ + p_) : (size_t)(MTOK + 16 + p_); dst[j] = *(const u32x4*)(PA + row_ * NPA + C_X + cc); } } while (0)
    BC_LOAD(r, 3);
#pragma unroll 1
    for (int kb = 3; kb >= 0; --kb) {
        if (kb > 0) BC_LOAD(rn, kb - 1);
        asm volatile("s_waitcnt vmcnt(0)" ::: "memory");
        __syncthreads();
#pragma unroll
        for (int h = 0; h < 2; ++h) {
            f32x4 x[7];
#pragma unroll
            for (int j = 0; j < 7; ++j) { const unsigned u0 = r[j][2 * h], u1 = r[j][2 * h + 1]; x[j] = (f32x4){bf_lo(u0), bf_hi(u0), bf_lo(u1), bf_hi(u1)}; }
#pragma unroll
            for (int i = 0; i < 4; ++i) { const f32x4 a = bs[h] + w[0][h] * x[i] + w[1][h] * x[i + 1] + w[2][h] * x[i + 2] + w[3][h] * x[i + 3];
                u32x2 pw; pw.x = cvt_pk_bf16(silu_(a[0]), silu_(a[1])); pw.y = cvt_pk_bf16(silu_(a[2]), silu_(a[3]));
                if (!dry) *(u32x2*)(PA + (size_t)(b * SEQ + 512 * kb + 4 * rg + i) * NPA + C_X + cc + 4 * h) = pw; }
        }
#pragma unroll
        for (int j = 0; j < 7; ++j) r[j] = rn[j];
    }
#undef BC_LOAD
    asm volatile("s_waitcnt vmcnt(0)" ::: "memory");
    __syncthreads();
    if (tid == 0 && !dry) { __builtin_amdgcn_fence(__ATOMIC_RELEASE, "agent"); asm volatile("s_waitcnt vmcnt(0)" ::: "memory"); __hip_atomic_fetch_add(flag, 1u, __ATOMIC_RELAXED, __HIP_MEMORY_SCOPE_AGENT); }
}
__device__ __forceinline__ void bc_conv_wait(unsigned* flag) {
    if (threadIdx.x == 0) { unsigned spins = 0;
        while (__hip_atomic_load(flag, __ATOMIC_RELAXED, __HIP_MEMORY_SCOPE_AGENT) < 8u) { __builtin_amdgcn_s_sleep(4); if (++spins > (1u << 22)) break; }
        __builtin_amdgcn_fence(__ATOMIC_ACQUIRE, "agent"); asm volatile("s_waitcnt vmcnt(0)" ::: "memory"); }
    __syncthreads();
}

struct MixArgs { bf16_t* PA; const float* GATES; float* SSQ; const float *igb, *fgb, *mng, *convw, *convb, *dtb, *alog, *sd, *sng; };

template <bool ML>
__device__ __forceinline__ void mixer_item(LAS unsigned char* L, const MixArgs& A, int item, const int wave_u, bool dry = false) {
    constexpr bool CONV = !ML;
    const int tid = threadIdx.x, lane = tid & 63, w = __builtin_amdgcn_readfirstlane(tid >> 6), fr = lane & 15, fq = lane >> 4;
    const int b = item >> 4;
    int h = 0, sl = 0, head = 0, g = 0;
    if (ML) { h = (item >> 2) & 3; sl = item & 3; } else { head = item & 15; g = head >> 2; }
    const int qcol = ML ? C_Q + 128 * h : C_X + 1536 + 128 * g;
    const int kcol = ML ? C_K + 128 * h : C_X + 1024 + 128 * g;
    const int vcol = ML ? C_V + 256 * h + 64 * sl : C_X + 64 * head;
    const int ocol = ML ? C_O + 256 * h + 64 * sl : C_Z + 64 * head;
    const int gi = ML ? h : 4 + g, part = ML ? sl : (head & 3);
    constexpr int NTL = ML ? 5 : 4;
    const float qscale = ML ? 0.08838834764831845f : 1.0f;
    bf16_t* PA = A.PA;
    LAS bf16_t* Ks = (LAS bf16_t*)(L + OFF_KS); LAS bf16_t* Ps = (LAS bf16_t*)(L + OFF_PS); LAS bf16_t* St = (LAS bf16_t*)(L + OFF_ST);
    LAS bf16_t* Vs = (LAS bf16_t*)(L + OFF_VS); LAS bf16_t* Vw = (LAS bf16_t*)(L + OFF_VW); LAS float* vec = (LAS float*)(L + OFF_VEC); LAS float* cwt = (LAS float*)(L + OFF_CW);
    const unsigned lbase = (unsigned)(uintptr_t)L;
    const int q4 = fr >> 2, p4 = fr & 3, t0 = 16 * w;
    const unsigned vs_tr = lbase + OFF_VS + (8 * fq + q4) * (VP * 2) + 8 * p4;
    const unsigned vw_tr = lbase + OFF_VW + (8 * fq + q4) * (VP * 2) + 8 * p4;
    const unsigned ks_tr = lbase + OFF_KS + (8 * fq + q4) * (KP * 2) + (16 * w + 4 * p4) * 2;
    const int rgq = tid >> 4, segq = tid & 15, rgv = tid >> 3, segv = tid & 7;

    for (int i = tid; i < 80 * KP * 2 / 16; i += NTHREADS) ((LAS u32x4*)St)[i] = (u32x4){0u, 0u, 0u, 0u};
    if (tid == 0) { vec[V_SC] = 0.f; vec[V_SC + 1] = 0.f; }
    if (CONV) {
        for (int i = tid; i < 1600; i += NTHREADS) {
            int r = i, base, W;
            if (r < 640) { base = qcol - C_X; W = 128; } else if (r < 1280) { r -= 640; base = kcol - C_X; W = 128; } else { r -= 1280; base = vcol - C_X; W = 64; }
            const int tap = r / W, col = r - tap * W;
            cwt[i] = tap < 4 ? A.convw[tap * 2048 + base + col] : A.convb[base + col];
        }
    }
    f32x4 sacc[NTL];
#pragma unroll
    for (int n = 0; n < NTL; ++n) sacc[n] = (f32x4){0.f, 0.f, 0.f, 0.f};
    float ib = 0.f, fb = 0.f, dtb = 0.f, Aneg = 0.f, Dh = 0.f;
    if (ML) { ib = A.igb[h]; fb = A.fgb[h]; } else { dtb = A.dtb[head]; Aneg = -__expf(A.alog[head]); Dh = A.sd[head]; }
    float gmulv[4];
#pragma unroll
    for (int n = 0; n < 4; ++n) gmulv[n] = ML ? A.mng[h * 256 + 64 * sl + 16 * n + fr] : A.sng[64 * head + 16 * n + fr];
    Raw<false, 4> RK, RQ; Raw<CONV, 2> RV;
    float gpre[4] = {0.f, 0.f, 0.f, 0.f};
#define MX_ISSUE_Q(cc) issue_task<false, 4>(RQ, PA, b, (cc), rgq, qcol + 8 * segq)
#define MX_ISSUE_KV(cc) do { issue_task<false, 4>(RK, PA, b, (cc), rgq, kcol + 8 * segq); issue_task<CONV, 2>(RV, PA, b, (cc), rgv, vcol + 8 * segv); } while (0)
#define MX_ISSUE_GATES(cc) do { if (w == 0) { _Pragma("unroll") for (int e = 0; e < 2; ++e) { \
                const int p_ = 2 * lane + e; const bool valid_ = ((cc) > 0) || (p_ >= 112); \
                const size_t grow_ = ((cc) == 0) ? (size_t)(MTOK + (valid_ ? p_ - 112 : 0)) : (size_t)(b * SEQ + ((cc) - 1) * 128 + p_); \
                if (ML) { gpre[2 * e] = A.GATES[grow_ * 32 + h]; gpre[2 * e + 1] = A.GATES[grow_ * 32 + 4 + h]; } else { gpre[2 * e] = A.GATES[grow_ * 32 + 8 + head]; } } } } while (0)
    Raw<true, 4> RK0;
    if constexpr (CONV) { issue_task<true, 4>(RK0, PA, b, 0, rgq, kcol + 8 * segq); issue_task<CONV, 2>(RV, PA, b, 0, rgv, vcol + 8 * segv); }
    else { MX_ISSUE_Q(0); MX_ISSUE_KV(0); }
    MX_ISSUE_GATES(0);
    __syncthreads();
    if (w == 0) { const int cc = 0; LAS float* vin = vec; LAS float* vout = vec;
        {
            const float m_prev = (cc > 0) ? vin[V_SC] : 0.f;
            float gl[2], il[2];
#pragma unroll
            for (int e = 0; e < 2; ++e) {
                const int p = 2 * lane + e; const bool valid = (cc > 0) || (p >= 112);
                if (ML) {
                    const float ip = gpre[2 * e] + ib, fp = gpre[2 * e + 1] + fb;
                    const float ic = 15.f * tanhf(ip * (1.f / 15.f)), fc = 15.f * tanhf(fp * (1.f / 15.f));
                    il[e] = valid ? ic : -INFINITY; gl[e] = valid ? -softplus_(-fc) : 0.f;
                } else {
                    const float dt = valid ? softplus_(gpre[2 * e] + dtb) : 0.f;
                    gl[e] = Aneg * dt; il[e] = dt > 0.f ? __logf(dt) : -INFINITY;
                }
            }
            if (cc + 1 < 17) MX_ISSUE_GATES(cc + 1);
            const float s1 = gl[0] + gl[1]; float incl = s1;
#pragma unroll
            for (int o = 1; o < 64; o <<= 1) { const float v = __shfl_up(incl, o); if (lane >= o) incl += v; }
            const float excl = incl - s1, bb0 = excl + gl[0], bb1 = incl, bL = __shfl(incl, 63);
            const float a0 = il[0] - bb0, a1 = il[1] - bb1;
            if (ML) {
                float im = fmaxf(a0, a1);
#pragma unroll
                for (int o = 1; o < 64; o <<= 1) { const float v = __shfl_up(im, o); if (lane >= o) im = fmaxf(im, v); }
                float em = __shfl_up(im, 1); if (lane == 0) em = -INFINITY;
                const float M0 = fmaxf(m_prev, fmaxf(em, a0)), M1v = fmaxf(m_prev, im), Ml = __shfl(M1v, 63);
                vout[V_RT + 2 * lane] = -M0 * L2E; vout[V_RT + 2 * lane + 1] = -M1v * L2E;
                vout[V_CS + 2 * lane] = a0 * L2E; vout[V_CS + 2 * lane + 1] = a1 * L2E;
                vout[V_ET + 2 * lane] = __expf(m_prev - M0) * qscale; vout[V_ET + 2 * lane + 1] = __expf(m_prev - M1v) * qscale;
                vout[V_EMT + 2 * lane] = __expf(-(bb0 + M0)); vout[V_EMT + 2 * lane + 1] = __expf(-(bb1 + M1v));
                vout[V_WS + 2 * lane] = __expf(a0 - Ml); vout[V_WS + 2 * lane + 1] = __expf(a1 - Ml);
                if (lane == 0) { vout[V_SC] = bL + Ml; vout[V_SC + 1] = __expf(m_prev - Ml); }
            } else {
                vout[V_RT + 2 * lane] = bb0 * L2E; vout[V_RT + 2 * lane + 1] = bb1 * L2E;
                vout[V_CS + 2 * lane] = a0 * L2E; vout[V_CS + 2 * lane + 1] = a1 * L2E;
                vout[V_ET + 2 * lane] = __expf(bb0); vout[V_ET + 2 * lane + 1] = __expf(bb1);
                vout[V_WS + 2 * lane] = __expf(bL + a0); vout[V_WS + 2 * lane + 1] = __expf(bL + a1);
                if (lane == 0) { vout[V_SC + 1] = __expf(bL); }
            }
        }
    }
    __syncthreads();
    { LAS float* vnx = vec;
        {
            if constexpr (!CONV) { stage_task<false, 128, 4, false>(RQ, cwt, 8 * segq, Ps, Ps, KP, 4 * rgq, vnx); stage_task<false, 128, 4, false>(RK, cwt, 8 * segq, Ks, Ks, KP, 4 * rgq, vnx); }
            else stage_task<true, 128, 4, false>(RK0, cwt + CW_K, 8 * segq, Ks, Ks, KP, 4 * rgq, vnx);
            stage_task<CONV, 64, 2, true>(RV, cwt + CW_V, 8 * segv, Vs, Vw, VP, 2 * rgv, vnx + V_WS);
            if (ML && tid < 256) {
                const int s = tid >> 1, half = tid & 1; const float wsv = vnx[V_WS + s];
                u32x4 o1 = (u32x4){0u, 0u, 0u, 0u}, o2 = o1;
                if (half == 0) { o1.x = 0x3f80u; o2.x = cvt_pk_bf16(wsv, 0.f); }
                *(LAS u32x4*)(Vs + s * VP + 64 + 8 * half) = o1; *(LAS u32x4*)(Vw + s * VP + 64 + 8 * half) = o2;
            }
        }
    }
    __syncthreads();

    for (int c = 0; c < 17; ++c) {
        LAS float* vcur = vec + (c & 1) * VEC_FLOATS; LAS float* vnx = vec + ((c + 1) & 1) * VEC_FLOATS;
        if (c > 0) {
            const int trow = t0 + 4 * fq; const size_t grow0 = (size_t)b * SEQ + (size_t)(c - 1) * 128 + trow;
            bf16_t oz[4][4];
#pragma unroll
            for (int n = 0; n < 4; ++n)
#pragma unroll
                for (int r = 0; r < 4; ++r) oz[n][r] = PA[(grow0 + r) * NPA + ocol + 16 * n + fr];
            bf16x8 qf[4];
#pragma unroll
            for (int ks = 0; ks < 4; ++ks) qf[ks] = *(const LAS bf16x8*)(Ps + (t0 + fr) * KP + 32 * ks + 8 * fq);
            LDS_WAIT();
            const float rtv = vcur[V_RT + t0 + fr]; const int t = t0 + fr;
#pragma unroll 1
            for (int i = 0; i <= w; ++i) {
                f32x4 sa = (f32x4){0.f, 0.f, 0.f, 0.f};
#pragma unroll
                for (int ks = 0; ks < 4; ++ks) { const bf16x8 kf = *(const LAS bf16x8*)(Ks + (16 * i + fr) * KP + 32 * ks + 8 * fq); sa = mfma16(kf, qf[ks], sa); }
                const f32x4 cs = *(const LAS f32x4*)(vcur + V_CS + 16 * i + 4 * fq);
                float pv[4];
#pragma unroll
                for (int r = 0; r < 4; ++r) { const int s = 16 * i + 4 * fq + r; const float e = __builtin_amdgcn_exp2f(rtv + cs[r]); pv[r] = (s <= t) ? sa[r] * qscale * e : 0.f; }
                u32x2 pw; pw.x = cvt_pk_bf16(pv[0], pv[1]); pw.y = cvt_pk_bf16(pv[2], pv[3]);
                *(LAS u32x2*)(Ps + t * KP + 16 * i + 4 * fq) = pw;
            }
            if (w < 7) *(LAS u32x2*)(Ps + t * KP + 16 * (w + 1) + 4 * fq) = (u32x2){0u, 0u};
            LDS_WAIT();
            f32x4 O[NTL];
#pragma unroll
            for (int n = 0; n < NTL; ++n) O[n] = (f32x4){0.f, 0.f, 0.f, 0.f};
#pragma unroll
            for (int ks = 0; ks < 4; ++ks) {
#pragma unroll
                for (int n = 0; n < NTL; ++n) { const bf16x8 sb = *(const LAS bf16x8*)(St + (16 * n + fr) * KP + 32 * ks + 8 * fq); O[n] = mfma16(qf[ks], sb, O[n]); }
                asm volatile("" ::: "memory");
            }
            const f32x4 etv = *(const LAS f32x4*)(vcur + V_ET + t0 + 4 * fq);
#pragma unroll
            for (int n = 0; n < NTL; ++n) O[n] = O[n] * etv;
#pragma unroll 1
            for (int kk = 0; kk <= (w >> 1); ++kk) {
                const bf16x8 pa = *(const LAS bf16x8*)(Ps + (t0 + fr) * KP + 32 * kk + 8 * fq);
                bf16x8 vb[NTL]; tr_frags<NTL, 4 * VP * 2>(vs_tr + kk * (32 * VP * 2), vb);
#pragma unroll
                for (int n = 0; n < NTL; ++n) O[n] = mfma16(pa, vb[n], O[n]);
            }
            float inv[4] = {1.f, 1.f, 1.f, 1.f};
            if (ML) { const f32x4 em = *(const LAS f32x4*)(vcur + V_EMT + trow);
#pragma unroll
                for (int r = 0; r < 4; ++r) { const float den = __shfl(O[NTL - 1][r], lane & 48); inv[r] = 1.0f / fmaxf(fabsf(den), em[r]); } }
            float ssq[4] = {0.f, 0.f, 0.f, 0.f};
#pragma unroll
            for (int n = 0; n < 4; ++n) {
                const int col = 16 * n + fr;
                const float gmul = gmulv[n];
#pragma unroll
                for (int r = 0; r < 4; ++r) {
                    bf16_t* addr = PA + (grow0 + r) * NPA + ocol + col; float val;
                    if (ML) { const float hraw = O[n][r] * inv[r]; ssq[r] += hraw * hraw; val = hraw * gmul * sigmoid_(bf1(oz[n][r])); }
                    else { const float x = bf1(Vs[(trow + r) * VP + col]); const float yg = (O[n][r] + Dh * x) * silu_(bf1(oz[n][r])); ssq[r] += yg * yg; val = yg * gmul; }
                    if (!dry) *addr = f2bf(val);
                }
            }
#pragma unroll
            for (int r = 0; r < 4; ++r) { float s = ssq[r]; s += __shfl_xor(s, 1); s += __shfl_xor(s, 2); s += __shfl_xor(s, 4); s += __shfl_xor(s, 8);
                if (fr == 0 && !dry) A.SSQ[((grow0 + r) * 8 + gi) * 4 + part] = s; }
        }
        if (c + 1 < 17) {
            if (w == 0) { const int cc = c + 1; LAS float* vin = vcur; LAS float* vout = vnx;
        {
                const float m_prev = (cc > 0) ? vin[V_SC] : 0.f;
                float gl[2], il[2];
#pragma unroll
                for (int e = 0; e < 2; ++e) {
                    const int p = 2 * lane + e; const bool valid = (cc > 0) || (p >= 112);
                    if (ML) {
                        const float ip = gpre[2 * e] + ib, fp = gpre[2 * e + 1] + fb;
                        const float ic = 15.f * tanhf(ip * (1.f / 15.f)), fc = 15.f * tanhf(fp * (1.f / 15.f));
                        il[e] = valid ? ic : -INFINITY; gl[e] = valid ? -softplus_(-fc) : 0.f;
                    } else {
                        const float dt = valid ? softplus_(gpre[2 * e] + dtb) : 0.f;
                        gl[e] = Aneg * dt; il[e] = dt > 0.f ? __logf(dt) : -INFINITY;
                    }
                }
                if (cc + 1 < 17) MX_ISSUE_GATES(cc + 1);
                const float s1 = gl[0] + gl[1]; float incl = s1;
#pragma unroll
                for (int o = 1; o < 64; o <<= 1) { const float v = __shfl_up(incl, o); if (lane >= o) incl += v; }
                const float excl = incl - s1, bb0 = excl + gl[0], bb1 = incl, bL = __shfl(incl, 63);
                const float a0 = il[0] - bb0, a1 = il[1] - bb1;
                if (ML) {
                    float im = fmaxf(a0, a1);
#pragma unroll
                    for (int o = 1; o < 64; o <<= 1) { const float v = __shfl_up(im, o); if (lane >= o) im = fmaxf(im, v); }
                    float em = __shfl_up(im, 1); if (lane == 0) em = -INFINITY;
                    const float M0 = fmaxf(m_prev, fmaxf(em, a0)), M1v = fmaxf(m_prev, im), Ml = __shfl(M1v, 63);
                    vout[V_RT + 2 * lane] = -M0 * L2E; vout[V_RT + 2 * lane + 1] = -M1v * L2E;
                    vout[V_CS + 2 * lane] = a0 * L2E; vout[V_CS + 2 * lane + 1] = a1 * L2E;
                    vout[V_ET + 2 * lane] = __expf(m_prev - M0) * qscale; vout[V_ET + 2 * lane + 1] = __expf(m_prev - M1v) * qscale;
                    vout[V_EMT + 2 * lane] = __expf(-(bb0 + M0)); vout[V_EMT + 2 * lane + 1] = __expf(-(bb1 + M1v));
                    vout[V_WS + 2 * lane] = __expf(a0 - Ml); vout[V_WS + 2 * lane + 1] = __expf(a1 - Ml);
                    if (lane == 0) { vout[V_SC] = bL + Ml; vout[V_SC + 1] = __expf(m_prev - Ml); }
                } else {
                    vout[V_RT + 2 * lane] = bb0 * L2E; vout[V_RT + 2 * lane + 1] = bb1 * L2E;
                    vout[V_CS + 2 * lane] = a0 * L2E; vout[V_CS + 2 * lane + 1] = a1 * L2E;
                    vout[V_ET + 2 * lane] = __expf(bb0); vout[V_ET + 2 * lane + 1] = __expf(bb1);
                    vout[V_WS + 2 * lane] = __expf(bL + a0); vout[V_WS + 2 * lane + 1] = __expf(bL + a1);
                    if (lane == 0) { vout[V_SC + 1] = __expf(bL); }
                }
            }
            }
            MX_ISSUE_Q(c + 1); MX_ISSUE_KV(c + 1);
        }
        {
            const float adec = vcur[V_SC + 1];
#pragma unroll
            for (int n = 0; n < NTL; ++n) sacc[n] = sacc[n] * adec;
#pragma unroll 1
            for (int kk = 0; kk < 4; ++kk) {
                const bf16x8 ka = tr_frag<4 * KP * 2>(ks_tr + kk * (32 * KP * 2));
                bf16x8 vb[NTL]; tr_frags<NTL, 4 * VP * 2>(vw_tr + kk * (32 * VP * 2), vb);
#pragma unroll
                for (int n = 0; n < NTL; ++n) sacc[n] = mfma16(ka, vb[n], sacc[n]);
            }
        }
        __syncthreads();
#pragma unroll
        for (int n = 0; n < NTL; ++n) { u32x2 sw; sw.x = cvt_pk_bf16(sacc[n][0], sacc[n][1]); sw.y = cvt_pk_bf16(sacc[n][2], sacc[n][3]);
            *(LAS u32x2*)(St + (16 * n + fr) * KP + 16 * w + 4 * fq) = sw; }
        if (c + 1 < 17) {
        {
                stage_task<false, 128, 4, false>(RQ, cwt, 8 * segq, Ps, Ps, KP, 4 * rgq, vnx);
                stage_task<false, 128, 4, false>(RK, cwt, 8 * segq, Ks, Ks, KP, 4 * rgq, vnx);
                stage_task<CONV, 64, 2, true>(RV, cwt + CW_V, 8 * segv, Vs, Vw, VP, 2 * rgv, vnx + V_WS);
                if (ML && tid < 256) {
                    const int s = tid >> 1, half = tid & 1; const float wsv = vnx[V_WS + s];
                    u32x4 o1 = (u32x4){0u, 0u, 0u, 0u}, o2 = o1;
                    if (half == 0) { o1.x = 0x3f80u; o2.x = cvt_pk_bf16(wsv, 0.f); }
                    *(LAS u32x4*)(Vs + s * VP + 64 + 8 * half) = o1; *(LAS u32x4*)(Vw + s * VP + 64 + 8 * half) = o2;
                }
            }
        }
        __syncthreads();
    }
    __syncthreads();
}
#undef MX_ISSUE_Q
#undef MX_ISSUE_KV
#undef MX_ISSUE_GATES
}

#define XB_TMO      128
#define XB_XCNT(j)  (256  + 64 * (j))
#define XB_XSUB(j)  (1280 + 64 * (j))
#define XB_XGEN(j)  (2304 + 64 * (j))
#define XB_TOP      3328
#define XB_TOPGEN   3392
#define XCD_BAR_WORDS 3456
#define XB_SPIN_CAP (1u << 18)

__device__ __forceinline__ unsigned xb_ld(unsigned* p)              { return __hip_atomic_load(p, __ATOMIC_RELAXED, __HIP_MEMORY_SCOPE_AGENT); }
__device__ __forceinline__ unsigned xb_add(unsigned* p, unsigned v) { return __hip_atomic_fetch_add(p, v, __ATOMIC_RELAXED, __HIP_MEMORY_SCOPE_AGENT); }
__device__ __forceinline__ unsigned xb_xcc_id() { return (unsigned)__builtin_amdgcn_s_getreg((3 << 11) | 20) & 0xFu; }
#define XB_SPIN(cond, bar) do { unsigned _sp = 0; while (cond) { __builtin_amdgcn_s_sleep(1); \
    if ((++_sp & 255u) == 0u) { if (xb_ld(&(bar)[XB_TMO])) break; if (_sp > XB_SPIN_CAP) { atomicAdd(&(bar)[XB_TMO], 1u); break; } } } } while (0)

struct XcdBarrier {
    unsigned* bar; unsigned x;
    volatile LAS unsigned* st;
};

__device__ __forceinline__ XcdBarrier xcd_barrier_post(unsigned* bar, volatile LAS unsigned* st) {
    XcdBarrier b; b.bar = bar; b.x = xb_xcc_id(); b.st = st;
    if (threadIdx.x == 0) (void)xb_add(&bar[XB_XCNT(b.x)], 1u);
    return b;
}
__device__ __forceinline__ void xcd_barrier_complete(unsigned* bar, unsigned x, unsigned& nloc, unsigned& nx) {
    const unsigned G = gridDim.x * gridDim.y * gridDim.z;
    unsigned sum, cnt, mine, sp = 0u;
    for (;;) {
        sum = 0u; cnt = 0u; mine = 0u;
#pragma unroll
        for (unsigned j = 0; j < 16; ++j) { const unsigned c = xb_ld(&bar[XB_XCNT(j)]); sum += c; cnt += (c > 0u) ? 1u : 0u; mine = (j == x) ? c : mine; }
        if (sum == G) break;
        __builtin_amdgcn_s_sleep(1);
        if ((++sp & 255u) == 0u) { if (xb_ld(&bar[XB_TMO])) break; if (sp > XB_SPIN_CAP) { atomicAdd(&bar[XB_TMO], 1u); break; } }
    }
    nloc = mine > 0u ? mine : 1u; nx = cnt > 0u ? cnt : 1u;
}

__device__ __forceinline__ void xcd_barrier(const XcdBarrier& b, const bool is_t0) {
    asm volatile("s_waitcnt vmcnt(0)" ::: "memory");
    __syncthreads();
    if (is_t0) {
        unsigned* bar = b.bar;
        __builtin_amdgcn_s_waitcnt(0);
        unsigned nloc = b.st[0], nx = b.st[1];
        if (nloc == 0u) { xcd_barrier_complete(bar, b.x, nloc, nx); b.st[0] = nloc; b.st[1] = nx; }
        const unsigned old = xb_add(&bar[XB_XSUB(b.x)], 1u);
        const unsigned gen = old / nloc;
        if (old + 1u == (gen + 1u) * nloc) {
            __builtin_amdgcn_fence(__ATOMIC_RELEASE, "agent");
            asm volatile("s_waitcnt vmcnt(0)" ::: "memory");
            const unsigned og = xb_add(&bar[XB_TOP], 1u);
            const unsigned tg = og / nx;
            if (og + 1u == (tg + 1u) * nx) xb_add(&bar[XB_TOPGEN], 1u);
            else XB_SPIN(xb_ld(&bar[XB_TOPGEN]) == tg, bar);
            __builtin_amdgcn_fence(__ATOMIC_ACQUIRE, "agent");
            xb_add(&bar[XB_XGEN(b.x)], 1u);
            asm volatile("s_waitcnt vmcnt(0)" ::: "memory");
        } else {
            XB_SPIN(xb_ld(&bar[XB_XGEN(b.x)]) == gen, bar);
            __builtin_amdgcn_fence(__ATOMIC_ACQUIRE, "agent");
            asm volatile("s_waitcnt vmcnt(0)" ::: "memory");
        }
    }
    __syncthreads();
}

__global__ void __launch_bounds__(NTHREADS, 2) fwd_kernel(Args a) {
    extern __shared__ __attribute__((aligned(16))) unsigned char lds[];
    cg::grid_group grid = cg::this_grid();
    LAS unsigned char* L = (LAS unsigned char*)lds;
    const int tid = threadIdx.x, lane = tid & 63, wave = __builtin_amdgcn_readfirstlane(tid >> 6);
    const int G = gridDim.x, bx = blockIdx.x;
    const int vcu = (G % 8 == 0) ? (bx % 8) * (G / 8) + bx / 8 : bx;
    const int gw = vcu * NWAVES + wave, NGW = G * NWAVES;
    unsigned char* ws = a.ws;
    bf16_t* PA = (bf16_t*)(ws + OFF_PA); bf16_t* U = (bf16_t*)(ws + OFF_U); bf16_t* WIN = (bf16_t*)(ws + OFF_WIN);
    float* GATES = (float*)(ws + OFF_GATES); float* SSQ = (float*)(ws + OFF_SSQ); float* SSQ2 = (float*)(ws + OFF_SSQ2); float* SSQ3 = (float*)(ws + OFF_SSQ3);
    bf16_t* WM = (bf16_t*)(ws + OFF_WM); bf16_t* WSP = (bf16_t*)(ws + OFF_WS); bf16_t* WO = (bf16_t*)(ws + OFF_WO); bf16_t* WFI = (bf16_t*)(ws + OFF_WFI); bf16_t* WFO = (bf16_t*)(ws + OFF_WFO);
    bf16_t* PB = (bf16_t*)a.out; float* OUT = a.out;
    LAS float* scr = (LAS float*)(L + wave * 8448);
    volatile LAS unsigned* MISC = (volatile LAS unsigned*)(L + LDS_BYTES - 16);
    if (tid < 2) MISC[tid] = 0u;
    LAS unsigned long long* PT = (LAS unsigned long long*)(L + LDS_BYTES - 16 - 256);
    if (tid < 20) PT[tid] = (unsigned long long)a.in[tid];
    __syncthreads();
#define INP(i) ((const float*)(((unsigned long long)(unsigned)__builtin_amdgcn_readfirstlane((int)(unsigned)(PT[i] >> 32)) << 32) | (unsigned long long)(unsigned)__builtin_amdgcn_readfirstlane((int)(unsigned)PT[i])))
    XcdBarrier xbar = xcd_barrier_post((unsigned*)(ws + WS_END + 4096), MISC);
#define GRID_BAR() xcd_barrier(xbar, threadIdx.x == 0)
#ifdef PROBE_T
    unsigned long long* TS = (unsigned long long*)(ws + WS_END); int n_ts = 0;
#define STAMP() do { if (bx == 0 && tid == 0) TS[n_ts] = __builtin_amdgcn_s_memrealtime(); ++n_ts; } while (0)
    STAMP();
#else
#define STAMP() do {} while (0)
#endif

#ifdef PROBE_P0X2
    for (int rep_ = 0; rep_ < 2; ++rep_) {
#else
    {
#endif
    for (int it = gw; it < 16 * 264; it += 2 * NGW) { if (it + NGW < 16 * 264) transpose_items2(INP(I_WIN), INW, DM, WIN, 1, scr, it, it + NGW, 264, lane); else transpose_item(INP(I_WIN), INW, DM, WIN, 1, nullptr, scr, it, 264, lane); }
    for (int m = gw; m < MTOK; m += 2 * NGW) rms_rows2_to_bf16(INP(I_X) + (size_t)m * DM, INP(I_X) + (size_t)(m + NGW) * DM, INP(I_N1G), U + (size_t)m * DM, U + (size_t)(m + NGW) * DM, lane);
    for (int m = MTOK + gw; m < M1; m += NGW) {
        if (m < MTOK + 16) rms_row_to_bf16(INP(I_META) + (size_t)(m - MTOK) * DM, INP(I_N1G), U + (size_t)m * DM, lane);
        else { u32x4* o = (u32x4*)(U + (size_t)m * DM) + lane; o[0] = (u32x4){0u, 0u, 0u, 0u}; o[64] = (u32x4){0u, 0u, 0u, 0u}; }
    }
    }
    GRID_BAR(); STAMP();
    if (a.ws == nullptr) grid.sync();
#ifdef PROBE_SYNC2
    grid.sync();
#endif
    {
        pg8::Gemm g{U, WIN, M1, N1, DM, DM}; pg8::StaticOrder S; S.init(M1, N1, G, bx);
        EpiProj E{PA, PB, GATES};
#ifndef NO_EpiProj
        pg8::gemm_phase<EpiProj, pg8::StaticOrder, true, true>(L, g, S, E, wave);
#endif
#ifdef PROBE_G1X2
        pg8::gemm_phase<EpiProj, pg8::StaticOrder, true, true>(L, g, S, E, wave);
#endif
    }
    GRID_BAR(); STAMP();
#ifdef PROBE_SYNC2
    GRID_BAR(); GRID_BAR();
#endif
    {
        __syncthreads();
        mx::MixArgs MA{PA, GATES, SSQ, INP(I_IGB), INP(I_FGB), INP(I_MNG), INP(I_CONVW), INP(I_CONVB), INP(I_DTB), INP(I_ALOG), INP(I_SD), INP(I_SNG)};
#ifdef PROBE_MIXA2
        for (int item = vcu; item < 128; item += G) mx::mixer_item<true>(L, MA, item, wave, true);
        asm volatile("" ::: "memory");
#endif
#ifdef PROBE_MIXB2
        for (int item = (vcu < 128 ? vcu + ((127 - vcu) / G + 1) * G : vcu); item < 256; item += G) mx::mixer_item<false>(L, MA, item - 128, wave, true);
        asm volatile("" ::: "memory");
#endif
#if defined(PROBE_MIXA2) || defined(PROBE_MIXB2)
        __syncthreads(); GRID_BAR();
#endif
        unsigned* FL = (unsigned*)(ws + WS_END + 4096 + 16384);
#ifdef PROBE_BC2
        for (int pt = vcu; pt < 256; pt += G) mx::bc_conv_pass(PA, pt >> 5, (pt >> 3) & 3, (pt >> 1) & 3, pt & 1, INP(I_CONVW), INP(I_CONVB), FL + 16 * (pt >> 3), true);
        __syncthreads(); GRID_BAR();
#endif
        for (int pt = vcu; pt < 256; pt += G) mx::bc_conv_pass(PA, pt >> 5, (pt >> 3) & 3, (pt >> 1) & 3, pt & 1, INP(I_CONVW), INP(I_CONVB), FL + 16 * (pt >> 3));
#ifndef NO_MIXA
        for (int item = vcu; item < 128; item += G) mx::mixer_item<true>(L, MA, item, wave);
#endif
        for (int it = vcu * NWAVES + wave; it < 4032 && vcu < 128; it += 128 * NWAVES) {
            int r = it;
            if (r < 512) { transpose_item(INP(I_MPROJ), DM, DM, WM, 0, nullptr, scr, r, 32, lane); continue; } r -= 512;
            if (r < 512) { transpose_item(INP(I_SPROJ), DM, DM, WSP, 0, nullptr, scr, r, 32, lane); continue; } r -= 512;
            if (r < 512) { transpose_item(INP(I_WOUT), DM, DM, WO, 0, nullptr, scr, r, 32, lane); continue; } r -= 512;
            if (r < 2816) { transpose_item(INP(I_WFI), 2 * DFF, DM, WFI, 2, INP(I_N2G), scr, r, 176, lane); continue; } r -= 2816;
            transpose_item(INP(I_WFO), DM, DFF, WFO, 0, nullptr, scr, r, 32, lane);
        }
        asm volatile("" ::: "memory");
#ifndef NO_MIXB
        for (int item = (vcu < 128 ? vcu + ((127 - vcu) / G + 1) * G : vcu); item < 256; item += G) {
            mx::bc_conv_wait(FL + 16 * (((item - 128) >> 4) * 4 + (((item - 128) & 15) >> 2)));
            mx::mixer_item<false>(L, MA, item - 128, wave);
        }
#endif
        for (int it = 4032 + (vcu - 128) * NWAVES + wave; it < 5760 && vcu >= 128; it += 128 * NWAVES) {
            int r = it - 4352;
            if (r < 0) { transpose_item(INP(I_WFI), 2 * DFF, DM, WFI, 2, INP(I_N2G), scr, it - 1536, 176, lane); continue; }
            transpose_item(INP(I_WFO), DM, DFF, WFO, 0, nullptr, scr, r, 32, lane);
        }
    }
    GRID_BAR(); STAMP();
#ifdef PROBE_SYNC2
    GRID_BAR(); GRID_BAR();
#endif
    {
        pg8::StaticOrder S; S.init(MTOK, DM, G, bx);
        LAS float* RT = (LAS float*)(L + 131072);
        pg8::Unit u0;
        if (S.next(0, u0)) {
            const int lr = tid >> 1, g0 = (tid & 1) * 4; const size_t row = (size_t)u0.pm * 256 + lr;
            float ms[4];
#pragma unroll
            for (int i = 0; i < 4; ++i) { const f32x4 s = *(const f32x4*)(SSQ + (row * 8 + g0 + i) * 4); ms[i] = ((s[0] + s[1]) + (s[2] + s[3])) * (1.0f / 256.f) + EPS; }
#pragma unroll
            for (int i = 1; i < 4; ++i) RT[lr * 8 + g0 + i] = sqrtf(ms[i] * __builtin_amdgcn_rcpf(ms[i - 1]));
            RT[lr * 8 + g0] = 1.0f / sqrtf(ms[3]);
        }
        __syncthreads();
        {
            pg8::Gemm g{PA + C_O, WM, MTOK, DM, DM, NPA};
            EpiBranchA E{PA, PB, RT}; HookRow H{RT, 0};
#ifndef NO_EpiBranchA
            pg8::gemm_phase<EpiBranchA, pg8::StaticOrder, true, true, HookRow>(L, g, S, E, wave, H);
#endif
        }
        {
            pg8::Gemm g{PA + C_Z, WSP, MTOK, DM, DM, NPA};
            EpiBranchB E{PB, PA, RT}; HookRow H{RT, 4};
#ifndef NO_EpiBranchB
            pg8::gemm_phase<EpiBranchB, pg8::StaticOrder, true, true, HookRow>(L, g, S, E, wave, H);
#endif
        }
    }
    GRID_BAR(); STAMP();
#ifdef PROBE_SYNC2
    GRID_BAR(); GRID_BAR();
#endif
    {
        pg8::Gemm g{PA + C_MERGED, WO, MTOK, DM, DM, NPA}; pg8::StaticOrder S; S.init(MTOK, DM, G, bx);
        EpiOut E{INP(I_X), OUT, PA, SSQ2};
#ifndef NO_EpiOut
        pg8::gemm_phase<EpiOut, pg8::StaticOrder, true, true>(L, g, S, E, wave);
#endif
#ifdef PROBE_G4X2
        pg8::gemm_phase<EpiOut, pg8::StaticOrder, true, true>(L, g, S, E, wave);
#endif
    }
    GRID_BAR(); STAMP();
#ifdef PROBE_SYNC2
    GRID_BAR(); GRID_BAR();
#endif
    {
        pg8::Gemm g{PA + C_H1B, WFI, MTOK, 2 * DFF, DM, NPA}; pg8::StaticOrder S; S.init(MTOK, 2 * DFF, G, bx);
        EpiFfnIn E{SSQ2, PA};
#ifndef NO_EpiFfnIn
        pg8::gemm_phase<EpiFfnIn, pg8::StaticOrder, true, true>(L, g, S, E, wave);
#endif
#ifdef PROBE_G5X2
        pg8::gemm_phase<EpiFfnIn, pg8::StaticOrder, true, true>(L, g, S, E, wave);
#endif
    }
    GRID_BAR(); STAMP();
#ifdef PROBE_SYNC2
    GRID_BAR(); GRID_BAR();
#endif
    {
        pg8::Gemm g{PA + C_ACT, WFO, MTOK, DM, DFF, NPA}; pg8::StaticOrder S; S.init(MTOK, DM, G, bx);
        EpiFfnOutNorm E{OUT, SSQ3, (unsigned*)(ws + WS_END + 32768), INP(I_NFG), PA};
        pg8::gemm_phase<EpiFfnOutNorm, pg8::StaticOrder, false, true>(L, g, S, E, wave);
    }
#ifdef PROBE_T
    GRID_BAR(); STAMP();
#ifdef PROBE_SYNC2
    GRID_BAR(); GRID_BAR();
#endif
    if (bx == 0) {
        const float da = (float)(TS[PROBE_A + 1] - TS[PROBE_A]) * 0.01f, db = (float)(TS[PROBE_B + 1] - TS[PROBE_B]) * 0.01f;
        if (tid == 0) OUT[0] = 50.f * da;
        for (int i = tid; i < (1 << 20); i += NTHREADS) OUT[1024 + i] = 0.25f * db;
    }
#endif
}

#undef INP
extern "C" void kernel_launch(void* const* d_in, const int* in_sizes, int n_in, void* d_out, int out_size, void* d_ws, size_t ws_size, hipStream_t stream) {
    static int grid = 0;
    if (grid == 0) {
        if (n_in != 20 || out_size != MTOK * DM || ws_size < WS_END) { fprintf(stderr, "kernel_launch: unexpected shapes (n_in %d out %d ws %zu)\n", n_in, out_size, ws_size); grid = -1; return; }
        int dev = 0, cus = 0, per_cu = 0;
        (void)hipGetDevice(&dev); (void)hipDeviceGetAttribute(&cus, hipDeviceAttributeMultiprocessorCount, dev);
        if (hipFuncSetAttribute((const void*)fwd_kernel, hipFuncAttributeMaxDynamicSharedMemorySize, LDS_BYTES) != hipSuccess) { fprintf(stderr, "kernel_launch: hipFuncSetAttribute failed\n"); grid = -1; return; }
        if (hipOccupancyMaxActiveBlocksPerMultiprocessor(&per_cu, (const void*)fwd_kernel, NTHREADS, LDS_BYTES) != hipSuccess || per_cu < 1) { fprintf(stderr, "kernel_launch: occupancy query gave %d\n", per_cu); per_cu = 1; }
        (void)hipGetLastError();
        grid = cus * 1;
        if (grid <= 0) grid = 256;
    }
    if (grid < 0) return;
    Args a{};
    for (int i = 0; i < 20; ++i) a.in[i] = (const float*)d_in[i];
    a.out = (float*)d_out; a.ws = (unsigned char*)d_ws;
    (void)hipMemsetAsync((unsigned char*)d_ws + WS_END + 4096, 0, 28672 + 64 * 256, stream);
    void* args[] = {&a};
    const hipError_t e = hipLaunchCooperativeKernel((const void*)fwd_kernel, dim3(grid), dim3(NTHREADS), args, LDS_BYTES, stream);
    if (e != hipSuccess) fprintf(stderr, "kernel_launch: cooperative launch failed: %s (grid %d)\n", hipGetErrorString(e), grid);
}
```

```cpp
#include <hip/hip_runtime.h>
#include <hip/hip_cooperative_groups.h>
#include <cstdio>
#include <cstdint>
namespace cg = cooperative_groups;
namespace pg8 {
#define PG8_LAS __attribute__((address_space(3)))
typedef unsigned short bf16_t;
typedef short bf16x8 __attribute__((ext_vector_type(8)));
typedef float f32x4 __attribute__((ext_vector_type(4)));
typedef unsigned u32x4 __attribute__((ext_vector_type(4)));
constexpr int BM = 256, BK = 64, HALF = 128, HTB = HALF * BK * 2  , STAGE_BYTES = 8 * HTB, NXCD = 8, WGM = 8;

__host__ __device__ __forceinline__ int lds_byte(int r, int c) { const int st = (r >> 4) * 2 + (c >> 5), rr = r & 15, cc = c & 31, ob = rr * 64 + cc * 2; return st * 1024 + (ob ^ (((ob >> 9) & 1) << 5)); }
__host__ __device__ __forceinline__ void stage_rc(int b, int& R, int& C) { const int st = b / 1024, sb = b % 1024, swz = sb ^ (((sb >> 9) & 1) << 5); R = (st >> 1) * 16 + swz / 64; C = (st & 1) * 32 + (swz % 64) / 2; }
__host__ __device__ __forceinline__ int perm32(int rho) { const int n = rho >> 4, i = rho & 15; return 8 * (i >> 2) + 4 * n + (i & 3); }

struct Unit { int pm, pn; };
struct Gemm { const bf16_t* A; const bf16_t* Bt; int M, N, K, lda; };

struct StaticOrder {
    int nM, nN, nwg, G, c;
    __host__ __device__ void init(int M, int N, int G_, int c_) { nM = M / BM; nN = N / BM; nwg = nM * nN; G = G_; c = c_; }
    __host__ __device__ bool next(int i, Unit& u) const {
        const long L = (long)i * G + c; if (L >= nwg) return false;
        int wgid = (int)L; { const int q = nwg / NXCD, r = nwg % NXCD, xcd = wgid % NXCD, off = wgid / NXCD; wgid = (xcd < r ? xcd * (q + 1) : r * (q + 1) + (xcd - r) * q) + off; }
        const int nig = WGM * nN, gid = wgid / nig, fm = gid * WGM, gsz = (nM - fm) < WGM ? (nM - fm) : WGM;
        u.pm = fm + ((wgid % nig) % gsz); u.pn = (wgid % nig) / gsz; return true;
    }
    __device__ __forceinline__ void a_ready(const Unit&) const {}
    __device__ __forceinline__ void done(const Unit&) const {}
};

__device__ __forceinline__ unsigned cvt_pk_bf16(float lo, float hi) { unsigned r; asm volatile("v_cvt_pk_bf16_f32 %0, %1, %2" : "=v"(r) : "v"(lo), "v"(hi)); return r; }
struct NoHook { static constexpr bool ENABLED = false; };
template <class Epi, class Sched, bool ALIGN_EPI = false, bool SP2 = false, class Hook = NoHook>
__device__ __forceinline__ void gemm_phase(PG8_LAS unsigned char* lds, const Gemm g, const Sched& S, const Epi& E, const int wave_u, const Hook& H = Hook()) {
    int tid_ = threadIdx.x; asm volatile("" : "+v"(tid_));
    const int tid = tid_, wid = __builtin_amdgcn_readfirstlane(tid >> 6), lane = tid & 63, wr = wid >> 2, wc = wid & 3, fr = lane & 15, fq = lane >> 4;
    const int K = g.K, nt = K / BK;
    unsigned voffA, voffB;
    { int R, C; stage_rc(tid * 16, R, C); const int Rb = Epi::PERM ? ((R & ~31) + perm32(R & 31)) : R;
        voffA = (unsigned)(R * g.lda + C) * 2u; voffB = (unsigned)(Rb * K + C) * 2u; }
    const size_t vstepA = (size_t)64 * g.lda * 2, vstepB = (size_t)64 * K * 2;
    const size_t kstep = (size_t)(BK * 2);
    const size_t hstep = (size_t)HALF * K * 2; const size_t hstepA = (size_t)HALF * g.lda * 2;
    const size_t tstep = 2 * hstep; const size_t tstepA = 2 * hstepA;
    const unsigned ldsw = (unsigned)wid * 1024u;
    const int aoff = lds_byte(wr * 64 + fr, fq * 8), boff = lds_byte(wc * 32 + fr, fq * 8);
#define PG8_SA(b, h) (((b) * 2 + (h)) * HTB)
#define PG8_SB(b, h) ((4 + (b) * 2 + (h)) * HTB)
#define PG8_STAGE(bufoff, gbase, ab) do { _Pragma("unroll") for (int _i = 0; _i < 2; ++_i) \
        __builtin_amdgcn_global_load_lds((const unsigned*)((const char*)(gbase) + (size_t)_i * vstep##ab + voff##ab), (PG8_LAS unsigned*)(lds + (bufoff) + ldsw + _i * 8192), 16, 0, 0); } while (0)
#define PG8_LDA(dst, b, h) do { _Pragma("unroll") for (int m = 0; m < 4; ++m) _Pragma("unroll") for (int k = 0; k < 2; ++k) dst[m][k] = *(const PG8_LAS bf16x8*)(lds + PG8_SA(b, h) + aoff + m * 2048 + k * 1024); } while (0)
#define PG8_LDB(dst, b, h) do { _Pragma("unroll") for (int n = 0; n < 2; ++n) _Pragma("unroll") for (int k = 0; k < 2; ++k) dst[n][k] = *(const PG8_LAS bf16x8*)(lds + PG8_SB(b, h) + boff + n * 2048 + k * 1024); } while (0)
#define PG8_MMA(ai, bj, At, Bt) do { __builtin_amdgcn_s_setprio(1); _Pragma("unroll") for (int m = 0; m < 4; ++m) _Pragma("unroll") for (int n = 0; n < 2; ++n) _Pragma("unroll") for (int k = 0; k < 2; ++k) \
        acc[ai][bj][m][n] = __builtin_amdgcn_mfma_f32_16x16x32_bf16(Bt[n][k], At[m][k], acc[ai][bj][m][n], 0, 0, 0); __builtin_amdgcn_s_setprio(0); } while (0)
#define PG8_WAIT_V(n) asm volatile("s_waitcnt vmcnt(" #n ")" ::: "memory")
#define PG8_WAIT_L(n) asm volatile("s_waitcnt lgkmcnt(" #n ")" ::: "memory")
#define PG8_BAR __builtin_amdgcn_s_barrier()
#define PG8_SCHED __builtin_amdgcn_sched_barrier(0)
    Unit cur, nxt; int ui = 0;
    if (!S.next(0, cur)) return;
    f32x4 acc[2][2][4][2];
#pragma unroll
    for (int a = 0; a < 2; ++a)
#pragma unroll
        for (int b = 0; b < 2; ++b)
#pragma unroll
            for (int m = 0; m < 4; ++m)
#pragma unroll
                for (int n = 0; n < 2; ++n) acc[a][b][m][n] = (f32x4){0.f, 0.f, 0.f, 0.f};
    bf16x8 At[4][2], B0[2][2], B1[2][2];
    const char* cA = (const char*)g.A + (size_t)cur.pm * tstepA; const char* cB = (const char*)g.Bt + (size_t)cur.pn * tstep;
    S.a_ready(cur);
    if constexpr (SP2) {
        PG8_STAGE(PG8_SB(0, 0), cB, B); PG8_STAGE(PG8_SB(0, 1), cB + hstep, B); PG8_STAGE(PG8_SA(0, 0), cA, A); PG8_STAGE(PG8_SA(0, 1), cA + hstepA, A);
        if (wr == 1) PG8_BAR;
        PG8_WAIT_V(2); PG8_BAR;
        PG8_STAGE(PG8_SB(1, 0), cB + kstep, B); PG8_STAGE(PG8_SA(1, 0), cA + kstep, A); PG8_STAGE(PG8_SB(1, 1), cB + hstep + kstep, B);
        PG8_WAIT_V(6); PG8_BAR;
    } else {
        PG8_STAGE(PG8_SB(0, 0), cB, B); PG8_STAGE(PG8_SA(0, 0), cA, A); PG8_STAGE(PG8_SB(0, 1), cB + hstep, B); PG8_STAGE(PG8_SA(0, 1), cA + hstepA, A);
        if (wr == 1) PG8_BAR;
        PG8_WAIT_V(4); PG8_BAR;
        PG8_STAGE(PG8_SB(1, 0), cB + kstep, B); PG8_STAGE(PG8_SA(1, 0), cA + kstep, A); PG8_STAGE(PG8_SB(1, 1), cB + hstep + kstep, B);
        PG8_WAIT_V(6); PG8_BAR;
    }
    for (;;) {
        const bool has_next = S.next(ui + 1, nxt);
        const char* nA = has_next ? (const char*)g.A + (size_t)nxt.pm * tstepA : cA; const char* nB = has_next ? (const char*)g.Bt + (size_t)nxt.pn * tstep : cB;
        for (int t = 0; t < nt; t += 2) {
            const bool last = (t == nt - 2);
            const char* a1 = cA + (size_t)(t + 1) * kstep;
            const char* a2 = last ? nA : cA + (size_t)(t + 2) * kstep; const char* b2 = last ? nB : cB + (size_t)(t + 2) * kstep;
            const char* a3 = a2 + kstep; const char* b3 = b2 + kstep;
            if (last && has_next) S.a_ready(nxt);
            if constexpr (Hook::ENABLED) { if (t > 0 && (t & 3) == 0) { PG8_SCHED; asm volatile("" ::: "memory"); H.seg(t >> 2, acc, cur, wr, wc, fr, fq); asm volatile("" ::: "memory"); PG8_SCHED; } }
            if constexpr (SP2) {
            PG8_LDB(B0, 0, 0); PG8_LDB(B1, 0, 1); PG8_SCHED; PG8_LDA(At, 0, 0); PG8_STAGE(PG8_SA(1, 1), a1 + hstepA, A);
            PG8_WAIT_V(8); PG8_WAIT_L(0); PG8_BAR; PG8_MMA(0, 0, At, B0); PG8_MMA(0, 1, At, B1); PG8_BAR; PG8_SCHED;
            PG8_LDA(At, 0, 1); PG8_STAGE(PG8_SB(0, 0), b2, B); PG8_STAGE(PG8_SB(0, 1), b2 + hstep, B); PG8_STAGE(PG8_SA(0, 0), a2, A);
            PG8_WAIT_V(8); PG8_WAIT_L(0); PG8_BAR; PG8_MMA(1, 0, At, B0); PG8_MMA(1, 1, At, B1); PG8_BAR; PG8_SCHED;
            PG8_LDB(B0, 1, 0); PG8_LDB(B1, 1, 1); PG8_SCHED; PG8_LDA(At, 1, 0); PG8_STAGE(PG8_SA(0, 1), a2 + hstepA, A);
            PG8_WAIT_V(8); PG8_WAIT_L(0); PG8_BAR; PG8_MMA(0, 0, At, B0); PG8_MMA(0, 1, At, B1); PG8_BAR; PG8_SCHED;
            PG8_LDA(At, 1, 1); PG8_STAGE(PG8_SB(1, 0), b3, B); PG8_STAGE(PG8_SB(1, 1), b3 + hstep, B); PG8_STAGE(PG8_SA(1, 0), a3, A);
            PG8_WAIT_V(8); PG8_WAIT_L(0); PG8_BAR; PG8_MMA(1, 0, At, B0); PG8_MMA(1, 1, At, B1); PG8_BAR; PG8_SCHED;
            } else {
            PG8_LDB(B0, 0, 0); PG8_SCHED; PG8_LDA(At, 0, 0); PG8_STAGE(PG8_SA(1, 1), a1 + hstepA, A);
            PG8_WAIT_L(8); PG8_BAR; PG8_WAIT_L(0); PG8_MMA(0, 0, At, B0); PG8_BAR; PG8_SCHED;
            PG8_LDB(B1, 0, 1); PG8_STAGE(PG8_SB(0, 0), b2, B);
            PG8_BAR; PG8_WAIT_L(0); PG8_MMA(0, 1, At, B1); PG8_BAR;
            PG8_LDA(At, 0, 1); PG8_STAGE(PG8_SA(0, 0), a2, A);
            PG8_BAR; PG8_WAIT_L(0); PG8_MMA(1, 0, At, B0); PG8_BAR; PG8_SCHED;
            PG8_STAGE(PG8_SB(0, 1), b2 + hstep, B);
            PG8_WAIT_V(6); PG8_BAR; PG8_MMA(1, 1, At, B1); PG8_BAR;
            PG8_LDB(B0, 1, 0); PG8_SCHED; PG8_LDA(At, 1, 0); PG8_STAGE(PG8_SA(0, 1), a2 + hstepA, A);
            PG8_WAIT_L(8); PG8_BAR; PG8_WAIT_L(0); PG8_MMA(0, 0, At, B0); PG8_BAR; PG8_SCHED;
            PG8_LDB(B1, 1, 1); PG8_STAGE(PG8_SB(1, 0), b3, B);
            PG8_BAR; PG8_WAIT_L(0); PG8_MMA(0, 1, At, B1); PG8_BAR;
            PG8_LDA(At, 1, 1); PG8_STAGE(PG8_SA(1, 0), a3, A);
            PG8_BAR; PG8_WAIT_L(0); PG8_MMA(1, 0, At, B0); PG8_BAR; PG8_SCHED;
            PG8_STAGE(PG8_SB(1, 1), b3 + hstep, B);
            PG8_WAIT_V(6); PG8_BAR; PG8_MMA(1, 1, At, B1); PG8_BAR;
            }
        }
        if constexpr (ALIGN_EPI) { if (wr == 0) PG8_BAR; }
        if constexpr (!Epi::AFTER_DRAIN) { E(acc, cur, wr, wc, fr, fq); S.done(cur); }
        if (!has_next) break;
#pragma unroll
        for (int a = 0; a < 2; ++a)
#pragma unroll
            for (int b = 0; b < 2; ++b)
#pragma unroll
                for (int m = 0; m < 4; ++m)
#pragma unroll
                    for (int n = 0; n < 2; ++n) acc[a][b][m][n] = (f32x4){0.f, 0.f, 0.f, 0.f};
        cur = nxt; cA = nA; cB = nB; ++ui;
        if constexpr (ALIGN_EPI) { if (wr == 1) PG8_BAR; }
    }
    PG8_WAIT_V(0);
    if constexpr (!ALIGN_EPI) { if (wr == 0) PG8_BAR; }
    PG8_BAR;
    if constexpr (Epi::AFTER_DRAIN) { E.fused(acc, cur, wr, wc, fr, fq, lds, wid, lane); S.done(cur); }
#undef PG8_SA
#undef PG8_SB
#undef PG8_STAGE
#undef PG8_LDA
#undef PG8_LDB
#undef PG8_MMA
#undef PG8_WAIT_V
#undef PG8_WAIT_L
#undef PG8_BAR
#undef PG8_SCHED
}
}

#define LAS __attribute__((address_space(3)))
typedef unsigned u32x2 __attribute__((ext_vector_type(2)));
typedef unsigned u32x4 __attribute__((ext_vector_type(4)));
typedef short s16x4 __attribute__((ext_vector_type(4)));
using pg8::bf16_t; using pg8::bf16x8; using pg8::f32x4; using pg8::cvt_pk_bf16;

constexpr int NWAVES = 8, NTHREADS = 512;
constexpr int BSZ = 8, SEQ = 2048, DM = 1024, MTOK = BSZ * SEQ;
constexpr int M1 = MTOK + 256;
constexpr int NPA = 6144, NPB = 2048, N1 = 8448, DFF = 2816, INW = 8216;
constexpr float EPS = 1e-6f;
constexpr int C_Q = 0, C_K = 512, C_V = 1024, C_O = 2048, C_Z = 3072, C_X = 4096;
constexpr int C_MERGED = 4096, C_H1B = 5120, C_ACT = 0;
constexpr size_t OFF_PA = 0;
constexpr size_t OFF_U = OFF_PA + (size_t)M1 * NPA * 2;
constexpr size_t OFF_WIN = OFF_U + (size_t)M1 * DM * 2;
constexpr size_t OFF_GATES = OFF_WIN + (size_t)N1 * DM * 2;
constexpr size_t OFF_SSQ = OFF_GATES + (size_t)M1 * 32 * 4;
constexpr size_t OFF_SSQ2 = OFF_SSQ + (size_t)MTOK * 32 * 4;
constexpr size_t OFF_SSQ3 = OFF_SSQ2 + (size_t)MTOK * 16 * 4;
constexpr size_t WS_END = OFF_SSQ3 + (size_t)MTOK * 16 * 4;
constexpr size_t OFF_WM = OFF_U, OFF_WS = OFF_WM + (size_t)DM * DM * 2, OFF_WO = OFF_WS + (size_t)DM * DM * 2;
constexpr size_t OFF_WFI = OFF_WO + (size_t)DM * DM * 2, OFF_WFO = OFF_WFI + (size_t)2 * DFF * DM * 2;
static_assert(OFF_WFO + (size_t)DM * DFF * 2 <= OFF_WIN, "late weight copies fit the U region");
static_assert(WS_END + 65536 <= 268435456ull, "workspace map");
constexpr int LDS_BYTES = 155648;

__device__ __forceinline__ float bf_lo(unsigned u) { return __uint_as_float(u << 16); }
__device__ __forceinline__ float bf_hi(unsigned u) { return __uint_as_float(u & 0xffff0000u); }
__device__ __forceinline__ float bf1(bf16_t h) { return __uint_as_float((unsigned)h << 16); }
__device__ __forceinline__ bf16_t f2bf(float f) { return (bf16_t)(cvt_pk_bf16(f, 0.f) & 0xffffu); }
__device__ __forceinline__ float sigmoid_(float x) { return __builtin_amdgcn_rcpf(1.f + __expf(-x)); }
__device__ __forceinline__ float silu_(float x) { return x * __builtin_amdgcn_rcpf(1.f + __expf(-x)); }
__device__ __forceinline__ float softplus_(float x) { return fmaxf(x, 0.f) + log1pf(__expf(-fabsf(x))); }
__device__ __forceinline__ float wave_sum(float v) {
#pragma unroll
    for (int o = 1; o < 64; o <<= 1) v += __shfl_xor(v, o);
    return v;
}
__device__ __forceinline__ void unpack8(const u32x4 u, float (&f)[8]) {
    f[0] = bf_lo(u.x); f[1] = bf_hi(u.x); f[2] = bf_lo(u.y); f[3] = bf_hi(u.y); f[4] = bf_lo(u.z); f[5] = bf_hi(u.z); f[6] = bf_lo(u.w); f[7] = bf_hi(u.w);
}
__device__ __forceinline__ u32x4 pack8(const float (&f)[8]) {
    u32x4 u; u.x = cvt_pk_bf16(f[0], f[1]); u.y = cvt_pk_bf16(f[2], f[3]); u.z = cvt_pk_bf16(f[4], f[5]); u.w = cvt_pk_bf16(f[6], f[7]); return u;
}
#define LDS_WAIT() asm volatile("s_waitcnt lgkmcnt(0)" ::: "memory")

struct Args { const float* in[20]; float* out; unsigned char* ws; };
enum { I_X = 0, I_META, I_N1G, I_WIN, I_IGB, I_FGB, I_MNG, I_MPROJ, I_CONVW, I_CONVB, I_DTB, I_ALOG, I_SD, I_SNG, I_SPROJ, I_WOUT, I_N2G, I_WFI, I_WFO, I_NFG };

struct EpiProj {
    static constexpr bool PERM = true, AFTER_DRAIN = false;
    bf16_t* PA; bf16_t* PB; float* GATES;
    __device__ __forceinline__ void operator()(const f32x4 (&acc)[2][2][4][2], const pg8::Unit& u, int wr, int wc, int fr, int fq) const {
        const int row0 = u.pm * 256 + wr * 64 + fr;
        if (u.pn == 32) {
            if (wc == 0) {
#pragma unroll
                for (int ai = 0; ai < 2; ++ai)
#pragma unroll
                    for (int m = 0; m < 4; ++m) { float* gp = GATES + (size_t)(row0 + ai * 128 + m * 16) * 32 + 8 * fq; *(f32x4*)gp = acc[ai][0][m][0]; *(f32x4*)(gp + 4) = acc[ai][0][m][1]; }
            }
            return;
        }
        bf16_t* base; int ld;
        if (u.pn < 24) { base = PA + 256 * u.pn; ld = NPA; }
        else { if (u.pm >= 64) return; base = PB + 256 * (u.pn - 24); ld = NPB; }
        const int col0 = wc * 32 + 8 * fq;
#pragma unroll
        for (int ai = 0; ai < 2; ++ai)
#pragma unroll
            for (int m = 0; m < 4; ++m) { bf16_t* rowp = base + (size_t)(row0 + ai * 128 + m * 16) * ld + col0;
#pragma unroll
                for (int bj = 0; bj < 2; ++bj) { const f32x4 v0 = acc[ai][bj][m][0], v1 = acc[ai][bj][m][1];
                    u32x4 w; w.x = cvt_pk_bf16(v0[0], v0[1]); w.y = cvt_pk_bf16(v0[2], v0[3]); w.z = cvt_pk_bf16(v1[0], v1[1]); w.w = cvt_pk_bf16(v1[2], v1[3]);
                    *(u32x4*)(rowp + bj * 128) = w; } }
    }
};
struct HookRow {
    static constexpr bool ENABLED = true;
    const LAS float* RT; int gbase;
    __device__ __forceinline__ void seg(int g1, f32x4 (&acc)[2][2][4][2], const pg8::Unit& u, int wr, int wc, int fr, int fq) const {
        const int ln_ = (int)__builtin_amdgcn_mbcnt_hi(~0u, __builtin_amdgcn_mbcnt_lo(~0u, 0u)); fr = ln_ & 15; fq = ln_ >> 4;
#pragma unroll
        for (int ai = 0; ai < 2; ++ai)
#pragma unroll
            for (int m = 0; m < 4; ++m) { const float r = RT[(ai * 128 + wr * 64 + m * 16 + fr) * 8 + gbase + g1];
#pragma unroll
                for (int bj = 0; bj < 2; ++bj)
#pragma unroll
                    for (int n = 0; n < 2; ++n) acc[ai][bj][m][n] = acc[ai][bj][m][n] * r; }
    }
};
struct EpiBranchA {
    static constexpr bool PERM = true, AFTER_DRAIN = false;
    bf16_t* PA; const bf16_t* PB; const LAS float* RT;
    __device__ __forceinline__ void operator()(const f32x4 (&acc)[2][2][4][2], const pg8::Unit& u, int wr, int wc, int fr, int fq) const {
        const int ln_ = (int)__builtin_amdgcn_mbcnt_hi(~0u, __builtin_amdgcn_mbcnt_lo(~0u, 0u)); fr = ln_ & 15; fq = ln_ >> 4;
        const int col0 = u.pn * 256 + wc * 32 + 8 * fq;
#pragma unroll
        for (int ai = 0; ai < 2; ++ai)
#pragma unroll
            for (int m = 0; m < 4; ++m) { const size_t row = (size_t)(u.pm * 256 + ai * 128 + wr * 64 + m * 16 + fr); const float r3 = RT[(ai * 128 + wr * 64 + m * 16 + fr) * 8];
#pragma unroll
                for (int bj = 0; bj < 2; ++bj) { const int col = col0 + bj * 128;
                    float g[8]; unpack8(*(const u32x4*)(PB + row * NPB + col), g);
                    float o[8];
#pragma unroll
                    for (int j = 0; j < 8; ++j) o[j] = sigmoid_(g[j]) * (acc[ai][bj][m][j >> 2][j & 3] * r3);
                    *(u32x4*)(PA + row * NPA + col) = pack8(o); } }
    }
};
struct EpiBranchB {
    static constexpr bool PERM = true, AFTER_DRAIN = false;
    const bf16_t* PB; bf16_t* PA; const LAS float* RT;
    __device__ __forceinline__ void operator()(const f32x4 (&acc)[2][2][4][2], const pg8::Unit& u, int wr, int wc, int fr, int fq) const {
        const int ln_ = (int)__builtin_amdgcn_mbcnt_hi(~0u, __builtin_amdgcn_mbcnt_lo(~0u, 0u)); fr = ln_ & 15; fq = ln_ >> 4;
        const int col0 = u.pn * 256 + wc * 32 + 8 * fq;
#pragma unroll
        for (int ai = 0; ai < 2; ++ai)
#pragma unroll
            for (int m = 0; m < 4; ++m) { const size_t row = (size_t)(u.pm * 256 + ai * 128 + wr * 64 + m * 16 + fr); const float r7 = RT[(ai * 128 + wr * 64 + m * 16 + fr) * 8 + 4];
#pragma unroll
                for (int bj = 0; bj < 2; ++bj) { const int col = col0 + bj * 128;
                    float g[8], tt[8]; unpack8(*(const u32x4*)(PB + row * NPB + 1024 + col), g); unpack8(*(const u32x4*)(PA + row * NPA + col), tt);
                    float o[8];
#pragma unroll
                    for (int j = 0; j < 8; ++j) o[j] = tt[j] + sigmoid_(g[j]) * (acc[ai][bj][m][j >> 2][j & 3] * r7);
                    *(u32x4*)(PA + row * NPA + C_MERGED + col) = pack8(o); } }
    }
};
struct EpiOut {
    static constexpr bool PERM = true, AFTER_DRAIN = false;
    const float* X; float* H1; bf16_t* PA; float* SSQ2;
    __device__ __forceinline__ void operator()(const f32x4 (&acc)[2][2][4][2], const pg8::Unit& u, int wr, int wc, int fr, int fq) const {
        const int col0 = u.pn * 256 + wc * 32 + 8 * fq;
#pragma unroll
        for (int ai = 0; ai < 2; ++ai)
#pragma unroll
            for (int m = 0; m < 4; ++m) { const size_t row = (size_t)(u.pm * 256 + ai * 128 + wr * 64 + m * 16 + fr); float s = 0.f;
#pragma unroll
                for (int bj = 0; bj < 2; ++bj) { const int col = col0 + bj * 128;
                    const f32x4 h0 = *(const f32x4*)(X + row * DM + col) + acc[ai][bj][m][0], h1 = *(const f32x4*)(X + row * DM + col + 4) + acc[ai][bj][m][1];
                    u32x4 w; w.x = cvt_pk_bf16(h0[0], h0[1]); w.y = cvt_pk_bf16(h0[2], h0[3]); w.z = cvt_pk_bf16(h1[0], h1[1]); w.w = cvt_pk_bf16(h1[2], h1[3]);
                    float hr[8]; unpack8(w, hr);
#pragma unroll
                    for (int j = 0; j < 8; ++j) s += hr[j] * hr[j];
                    *(u32x4*)(PA + row * NPA + C_H1B + col) = w; }
                s += __shfl_xor(s, 16); s += __shfl_xor(s, 32);
                if (fq == 0) SSQ2[row * 16 + u.pn * 4 + wc] = s; }
    }
};
struct EpiFfnIn {
    static constexpr bool PERM = true, AFTER_DRAIN = false;
    const float* SSQ2; bf16_t* PA;
    __device__ __forceinline__ void operator()(const f32x4 (&acc)[2][2][4][2], const pg8::Unit& u, int wr, int wc, int fr, int fq) const {
        const int col0 = C_ACT + u.pn * 128 + wc * 32 + 8 * fq;
#pragma unroll
        for (int ai = 0; ai < 2; ++ai)
#pragma unroll
            for (int m = 0; m < 4; ++m) { const size_t row = (size_t)(u.pm * 256 + wr * 64 + fr + ai * 128 + m * 16);
                const f32x4* sp = (const f32x4*)(SSQ2 + row * 16); const f32x4 s0 = sp[0], s1 = sp[1], s2 = sp[2], s3 = sp[3];
                const float ss = ((s0[0] + s0[1]) + (s0[2] + s0[3])) + ((s1[0] + s1[1]) + (s1[2] + s1[3])) + ((s2[0] + s2[1]) + (s2[2] + s2[3])) + ((s3[0] + s3[1]) + (s3[2] + s3[3]));
                const float r = 1.0f / sqrtf(ss * (1.0f / DM) + EPS);
                float o[8];
#pragma unroll
                for (int n = 0; n < 2; ++n)
#pragma unroll
                    for (int j = 0; j < 4; ++j) { const float g = r * acc[ai][0][m][n][j], up = r * acc[ai][1][m][n][j]; o[4 * n + j] = silu_(g) * up; }
                *(u32x4*)(PA + row * NPA + col0) = pack8(o); }
    }
};
struct EpiFfnOutNorm {
    static constexpr bool PERM = true, AFTER_DRAIN = true;
    float* H; float* SSQ3; unsigned* cnt; const float* gf; const bf16_t* PA;
    __device__ __forceinline__ void fused(f32x4 (&acc)[2][2][4][2], const pg8::Unit& u, int wr, int wc, int fr, int fq, PG8_LAS unsigned char* lds, int wid, int lane) const {
        const int col0 = u.pn * 256 + wc * 32 + 8 * fq;
#pragma unroll
        for (int ai = 0; ai < 2; ++ai)
#pragma unroll
            for (int m = 0; m < 4; ++m) { const size_t row = (size_t)(u.pm * 256 + ai * 128 + wr * 64 + m * 16 + fr); float s = 0.f;
#pragma unroll
                for (int bj = 0; bj < 2; ++bj) { const int col = col0 + bj * 128;
                    float hb[8]; unpack8(*(const u32x4*)(PA + row * NPA + C_H1B + col), hb);
#pragma unroll
                    for (int n = 0; n < 2; ++n) { const f32x4 hv = (f32x4){hb[4 * n], hb[4 * n + 1], hb[4 * n + 2], hb[4 * n + 3]} + acc[ai][bj][m][n];
                        acc[ai][bj][m][n] = hv; s += (hv[0] * hv[0] + hv[1] * hv[1]) + (hv[2] * hv[2] + hv[3] * hv[3]); } }
                s += __shfl_xor(s, 16); s += __shfl_xor(s, 32);
                if (fq == 0) __hip_atomic_store(SSQ3 + row * 16 + u.pn * 4 + wc, s, __ATOMIC_RELAXED, __HIP_MEMORY_SCOPE_AGENT);
                if (m & 1) asm volatile("" ::: "memory"); }
        asm volatile("s_waitcnt vmcnt(0)" ::: "memory");
        unsigned* c = cnt + 64 * u.pm;
        if (lane == 0) __hip_atomic_fetch_add(c, 1u, __ATOMIC_RELAXED, __HIP_MEMORY_SCOPE_AGENT);
        { unsigned spins = 0;
          while ((unsigned)__builtin_amdgcn_readfirstlane(__hip_atomic_load(c, __ATOMIC_RELAXED, __HIP_MEMORY_SCOPE_AGENT)) < 32u) { __builtin_amdgcn_s_sleep(2); if (++spins > (1u << 22)) break; } }
        __builtin_amdgcn_fence(__ATOMIC_ACQUIRE, "agent");
#pragma unroll
        for (int ai = 0; ai < 2; ++ai)
#pragma unroll
            for (int m = 0; m < 4; ++m) { const size_t row = (size_t)(u.pm * 256 + ai * 128 + wr * 64 + m * 16 + fr);
                const unsigned long long* sp = (const unsigned long long*)(SSQ3 + row * 16); float ss = 0.f;
#pragma unroll
                for (int i = 0; i < 8; ++i) { const unsigned long long v = __hip_atomic_load(sp + i, __ATOMIC_RELAXED, __HIP_MEMORY_SCOPE_AGENT); ss += __uint_as_float((unsigned)v) + __uint_as_float((unsigned)(v >> 32)); }
                const float rstd = 1.0f / sqrtf(ss * (1.0f / DM) + EPS);
#pragma unroll
                for (int bj = 0; bj < 2; ++bj)
#pragma unroll
                    for (int n = 0; n < 2; ++n) { const int col = col0 + bj * 128 + 4 * n;
                        const f32x4 gg = *(const f32x4*)(gf + col);
                        *(f32x4*)(H + row * DM + col) = acc[ai][bj][m][n] * rstd * gg; }
                if (m & 1) asm volatile("" ::: "memory"); }
    }
};
struct EpiFfnOutDry {
    static constexpr bool PERM = false, AFTER_DRAIN = false;
    const float* H; float* D; float* SSQ3;
    __device__ __forceinline__ void operator()(const f32x4 (&acc)[2][2][4][2], const pg8::Unit& u, int wr, int wc, int fr, int fq) const {
        const int col0 = u.pn * 256 + wc * 32 + 4 * fq;
#pragma unroll
        for (int ai = 0; ai < 2; ++ai)
#pragma unroll
            for (int m = 0; m < 4; ++m) { const size_t row = (size_t)(u.pm * 256 + ai * 128 + wr * 64 + m * 16 + fr); float s = 0.f;
#pragma unroll
                for (int bj = 0; bj < 2; ++bj)
#pragma unroll
                    for (int n = 0; n < 2; ++n) { const int col = col0 + bj * 128 + n * 16;
                        const f32x4 hv = *(const f32x4*)(H + row * DM + col) + acc[ai][bj][m][n];
                        *(f32x4*)(D + row * 3072 + col) = hv; s += (hv[0] * hv[0] + hv[1] * hv[1]) + (hv[2] * hv[2] + hv[3] * hv[3]); }
                s += __shfl_xor(s, 16); s += __shfl_xor(s, 32);
                if (fq == 0) SSQ3[row * 16 + u.pn * 4 + wc] = s; }
    }
};
__device__ __forceinline__ int src_col(int mode, int n) {
    if (mode == 0) return n;
    if (mode == 1) {
        if (n < 3072) return n;
        if (n < 6144) return n + 8;
        if (n < 8192) return n + 24;
        if (n < 8200) return 3072 + (n - 8192);
        if (n < 8216) return 6152 + (n - 8200);
        return -1;
    }
    const int p = n >> 8, r = n & 255;
    return r < 128 ? 128 * p + r : DFF + 128 * p + (r - 128);
}
__device__ __forceinline__ void transpose_item(const float* W, int ldw, int K, bf16_t* WT, int mode, const float* kscale, LAS float* scr, int item, int nblk, int lane) {
    const int kb = item / nblk, nb = item - kb * nblk, k0 = 64 * kb, n0 = 32 * nb;
    const int nq = lane & 7, kr = lane >> 3;
    const int sc = src_col(mode, n0 + 4 * nq);
#pragma unroll
    for (int i = 0; i < 8; ++i) { const int kk = 8 * i + kr; f32x4 v = (f32x4){0.f, 0.f, 0.f, 0.f}; if (sc >= 0) v = *(const f32x4*)(W + (size_t)(k0 + kk) * ldw + sc);
        if (kscale) v = v * kscale[k0 + kk];
        LAS float* d = scr + kk * 33 + 4 * nq; d[0] = v[0]; d[1] = v[1]; d[2] = v[2]; d[3] = v[3]; }
    LDS_WAIT();
    const int c = lane & 7;
#pragma unroll
    for (int j = 0; j < 4; ++j) { const int n = (lane >> 3) + 8 * j; const LAS float* s = scr + (8 * c) * 33 + n;
        u32x4 o; o.x = cvt_pk_bf16(s[0 * 33], s[1 * 33]); o.y = cvt_pk_bf16(s[2 * 33], s[3 * 33]); o.z = cvt_pk_bf16(s[4 * 33], s[5 * 33]); o.w = cvt_pk_bf16(s[6 * 33], s[7 * 33]);
        *(u32x4*)(WT + (size_t)(n0 + n) * K + k0 + 8 * c) = o; }
    LDS_WAIT();
}
__device__ __forceinline__ void transpose_items2(const float* W, int ldw, int K, bf16_t* WT, int mode, LAS float* scr, int itemA, int itemB, int nblk, int lane) {
    const int nq = lane & 7, kr = lane >> 3, c = lane & 7;
    int k0[2], n0[2], sc[2]; f32x4 v[2][8];
#pragma unroll
    for (int q = 0; q < 2; ++q) { const int item = q ? itemB : itemA; const int kb = item / nblk, nb = item - kb * nblk; k0[q] = 64 * kb; n0[q] = 32 * nb; sc[q] = src_col(mode, n0[q] + 4 * nq);
#pragma unroll
        for (int i = 0; i < 8; ++i) { v[q][i] = (f32x4){0.f, 0.f, 0.f, 0.f}; if (sc[q] >= 0) v[q][i] = *(const f32x4*)(W + (size_t)(k0[q] + 8 * i + kr) * ldw + sc[q]); } }
#pragma unroll
    for (int q = 0; q < 2; ++q) {
#pragma unroll
        for (int i = 0; i < 8; ++i) { LAS float* d = scr + (8 * i + kr) * 33 + 4 * nq; d[0] = v[q][i][0]; d[1] = v[q][i][1]; d[2] = v[q][i][2]; d[3] = v[q][i][3]; }
        LDS_WAIT();
#pragma unroll
        for (int j = 0; j < 4; ++j) { const int n = (lane >> 3) + 8 * j; const LAS float* s = scr + (8 * c) * 33 + n;
            u32x4 o; o.x = cvt_pk_bf16(s[0 * 33], s[1 * 33]); o.y = cvt_pk_bf16(s[2 * 33], s[3 * 33]); o.z = cvt_pk_bf16(s[4 * 33], s[5 * 33]); o.w = cvt_pk_bf16(s[6 * 33], s[7 * 33]);
            *(u32x4*)(WT + (size_t)(n0[q] + n) * K + k0[q] + 8 * c) = o; }
        LDS_WAIT();
    }
}
__device__ __forceinline__ void rms_row_to_bf16(const float* xrow, const float* g, bf16_t* orow, int lane) {
    f32x4 v[4]; float s = 0.f;
#pragma unroll
    for (int j = 0; j < 4; ++j) { v[j] = *(const f32x4*)(xrow + 4 * lane + 256 * j); s += (v[j][0] * v[j][0] + v[j][1] * v[j][1]) + (v[j][2] * v[j][2] + v[j][3] * v[j][3]); }
    const float rstd = 1.0f / sqrtf(wave_sum(s) * (1.0f / DM) + EPS);
#pragma unroll
    for (int j = 0; j < 4; ++j) { const f32x4 gg = *(const f32x4*)(g + 4 * lane + 256 * j); const f32x4 o = v[j] * rstd * gg;
        u32x2 w; w.x = cvt_pk_bf16(o[0], o[1]); w.y = cvt_pk_bf16(o[2], o[3]); *(u32x2*)(orow + 4 * lane + 256 * j) = w; }
}

__device__ __forceinline__ void rms_rows2_to_bf16(const float* x0, const float* x1, const float* g, bf16_t* o0, bf16_t* o1, int lane) {
    f32x4 v[4], w[4]; float s = 0.f, q = 0.f;
#pragma unroll
    for (int j = 0; j < 4; ++j) { v[j] = *(const f32x4*)(x0 + 4 * lane + 256 * j); w[j] = *(const f32x4*)(x1 + 4 * lane + 256 * j); }
#pragma unroll
    for (int j = 0; j < 4; ++j) { s += (v[j][0] * v[j][0] + v[j][1] * v[j][1]) + (v[j][2] * v[j][2] + v[j][3] * v[j][3]); q += (w[j][0] * w[j][0] + w[j][1] * w[j][1]) + (w[j][2] * w[j][2] + w[j][3] * w[j][3]); }
    const float r0 = 1.0f / sqrtf(wave_sum(s) * (1.0f / DM) + EPS), r1 = 1.0f / sqrtf(wave_sum(q) * (1.0f / DM) + EPS);
#pragma unroll
    for (int j = 0; j < 4; ++j) { const f32x4 gg = *(const f32x4*)(g + 4 * lane + 256 * j); const f32x4 a = v[j] * r0 * gg, b = w[j] * r1 * gg;
        u32x2 pa, pb; pa.x = cvt_pk_bf16(a[0], a[1]); pa.y = cvt_pk_bf16(a[2], a[3]); pb.x = cvt_pk_bf16(b[0], b[1]); pb.y = cvt_pk_bf16(b[2], b[3]);
        *(u32x2*)(o0 + 4 * lane + 256 * j) = pa; *(u32x2*)(o1 + 4 * lane + 256 * j) = pb; }
}

namespace mx {
constexpr int KP = 136, VP = 88;
constexpr int OFF_KS = 0, OFF_PS = 34816, OFF_ST = 69632, OFF_VS = 91392, OFF_VW = 113920, OFF_VEC = 136448, VEC_FLOATS = 704, OFF_CW = OFF_VEC + 2 * VEC_FLOATS * 4;
constexpr int V_RT = 0, V_CS = 128, V_ET = 256, V_WS = 384, V_EMT = 512, V_SC = 640;
constexpr int CW_Q = 0, CW_K = 640, CW_V = 1280;
constexpr float L2E = 1.4426950408889634f;
static_assert(OFF_CW + 4 * 1600 <= LDS_BYTES - 16, "mixer LDS");

__device__ __forceinline__ const bf16_t* rowp(const bf16_t* PA, int b, int c, int p) {
    if (p < 0) { c -= 1; p += 128; }
    if (c < 0) return nullptr;
    if (c == 0) { if (p < 112) return nullptr; return PA + (size_t)(MTOK + p - 112) * NPA; }
    return PA + (size_t)(b * SEQ + (c - 1) * 128 + p) * NPA;
}
template <int OFF> __device__ __forceinline__ bf16x8 tr_frag(unsigned addr) {
    s16x4 lo, hi;
    asm volatile("ds_read_b64_tr_b16 %0, %2\n\tds_read_b64_tr_b16 %1, %2 offset:%3\n\ts_waitcnt lgkmcnt(0)" : "=&v"(lo), "=&v"(hi) : "v"(addr), "i"(OFF) : "memory");
    bf16x8 r; r[0] = lo[0]; r[1] = lo[1]; r[2] = lo[2]; r[3] = lo[3]; r[4] = hi[0]; r[5] = hi[1]; r[6] = hi[2]; r[7] = hi[3]; return r;
}
__device__ __forceinline__ bf16x8 mk8(s16x4 lo, s16x4 hi) { bf16x8 r; r[0] = lo[0]; r[1] = lo[1]; r[2] = lo[2]; r[3] = lo[3]; r[4] = hi[0]; r[5] = hi[1]; r[6] = hi[2]; r[7] = hi[3]; return r; }
template <int NT, int OFF> __device__ __forceinline__ void tr_frags(unsigned addr, bf16x8 (&f)[NT]) {
    s16x4 a0, b0, a1, b1, a2, b2, a3, b3, a4, b4;
    if constexpr (NT == 5) {
        asm volatile("ds_read_b64_tr_b16 %0, %10\n\tds_read_b64_tr_b16 %1, %10 offset:%11\n\tds_read_b64_tr_b16 %2, %10 offset:32\n\tds_read_b64_tr_b16 %3, %10 offset:%12\n\t"
                     "ds_read_b64_tr_b16 %4, %10 offset:64\n\tds_read_b64_tr_b16 %5, %10 offset:%13\n\tds_read_b64_tr_b16 %6, %10 offset:96\n\tds_read_b64_tr_b16 %7, %10 offset:%14\n\t"
                     "ds_read_b64_tr_b16 %8, %10 offset:128\n\tds_read_b64_tr_b16 %9, %10 offset:%15\n\ts_waitcnt lgkmcnt(0)"
                     : "=&v"(a0), "=&v"(b0), "=&v"(a1), "=&v"(b1), "=&v"(a2), "=&v"(b2), "=&v"(a3), "=&v"(b3), "=&v"(a4), "=&v"(b4)
                     : "v"(addr), "i"(OFF), "i"(OFF + 32), "i"(OFF + 64), "i"(OFF + 96), "i"(OFF + 128) : "memory");
        f[4] = mk8(a4, b4);
    } else {
        asm volatile("ds_read_b64_tr_b16 %0, %8\n\tds_read_b64_tr_b16 %1, %8 offset:%9\n\tds_read_b64_tr_b16 %2, %8 offset:32\n\tds_read_b64_tr_b16 %3, %8 offset:%10\n\t"
                     "ds_read_b64_tr_b16 %4, %8 offset:64\n\tds_read_b64_tr_b16 %5, %8 offset:%11\n\tds_read_b64_tr_b16 %6, %8 offset:96\n\tds_read_b64_tr_b16 %7, %8 offset:%12\n\ts_waitcnt lgkmcnt(0)"
                     : "=&v"(a0), "=&v"(b0), "=&v"(a1), "=&v"(b1), "=&v"(a2), "=&v"(b2), "=&v"(a3), "=&v"(b3)
                     : "v"(addr), "i"(OFF), "i"(OFF + 32), "i"(OFF + 64), "i"(OFF + 96) : "memory");
    }
    f[0] = mk8(a0, b0); f[1] = mk8(a1, b1); f[2] = mk8(a2, b2); f[3] = mk8(a3, b3);
}
__device__ __forceinline__ f32x4 mfma16(bf16x8 a, bf16x8 b, f32x4 c) { return __builtin_amdgcn_mfma_f32_16x16x32_bf16(a, b, c, 0, 0, 0); }

template <bool CONV, int ROWS> struct Raw { u32x4 r[ROWS + (CONV ? 3 : 0)]; };
template <bool CONV, int ROWS> __device__ __forceinline__ void issue_task(Raw<CONV, ROWS>& R, const bf16_t* PA, int b, int c, int rg, int col) {
    asm volatile("" : "+s"(c));
    const int rbase = (c == 0) ? MTOK - 112 : b * SEQ + (c - 1) * 128;
    const int hbase = (c == 1) ? MTOK + 16 : rbase;
    const int minp = (c == 0) ? 112 : -3;
    const int p0 = ROWS * rg - (CONV ? 3 : 0);
    const unsigned off0 = (unsigned)(rbase + p0) * (unsigned)(NPA * 2) + (unsigned)col * 2u, hoff0 = (unsigned)(hbase + p0) * (unsigned)(NPA * 2) + (unsigned)col * 2u;
#pragma unroll
    for (int j = 0; j < ROWS + (CONV ? 3 : 0); ++j) { const int p = p0 + j; const unsigned off = (p < 0 ? hoff0 : off0) + (unsigned)(j * NPA * 2);
        R.r[j] = (u32x4){0u, 0u, 0u, 0u}; if (p >= minp) R.r[j] = *(const u32x4*)((const char*)PA + off); }
}
template <bool CONV, int W, int ROWS, bool DUAL> __device__ __forceinline__ void stage_task(const Raw<CONV, ROWS>& R, const LAS float* cw, int col, LAS bf16_t* dst, LAS bf16_t* dst2, int pitch, int row0, const LAS float* wsv) {
#pragma unroll
    for (int h = 0; h < 2; ++h) {
        f32x4 w0, w1, w2, w3, bs;
        if constexpr (CONV) { w0 = *(const LAS f32x4*)(cw + 0 * W + col + 4 * h); w1 = *(const LAS f32x4*)(cw + 1 * W + col + 4 * h); w2 = *(const LAS f32x4*)(cw + 2 * W + col + 4 * h);
                              w3 = *(const LAS f32x4*)(cw + 3 * W + col + 4 * h); bs = *(const LAS f32x4*)(cw + 4 * W + col + 4 * h); }
        f32x4 x[ROWS + (CONV ? 3 : 0)];
#pragma unroll
        for (int j = 0; j < ROWS + (CONV ? 3 : 0); ++j) { const unsigned u0 = R.r[j][2 * h], u1 = R.r[j][2 * h + 1]; x[j] = (f32x4){bf_lo(u0), bf_hi(u0), bf_lo(u1), bf_hi(u1)}; }
#pragma unroll
        for (int i = 0; i < ROWS; ++i) {
            f32x4 v;
            if constexpr (CONV) { const f32x4 a = bs + w0 * x[i] + w1 * x[i + 1] + w2 * x[i + 2] + w3 * x[i + 3]; v = (f32x4){silu_(a[0]), silu_(a[1]), silu_(a[2]), silu_(a[3])}; }
            else v = x[i];
            u32x2 pw; pw.x = cvt_pk_bf16(v[0], v[1]); pw.y = cvt_pk_bf16(v[2], v[3]);
            *(LAS u32x2*)(dst + (row0 + i) * pitch + col + 4 * h) = pw;
            if constexpr (DUAL) { const float s = wsv[row0 + i]; u32x2 pw2; pw2.x = cvt_pk_bf16(v[0] * s, v[1] * s); pw2.y = cvt_pk_bf16(v[2] * s, v[3] * s);
                *(LAS u32x2*)(dst2 + (row0 + i) * pitch + col + 4 * h) = pw2; }
        }
        asm volatile("" ::: "memory");
    }
}

__device__ __forceinline__ void bc_conv_pass(bf16_t* PA, int b, int g, int sl, int isC, const float* convw, const float* convb, unsigned* flag, bool dry = false) {
    const int tid = threadIdx.x, rg = tid >> 2, sg = tid & 3;
    const int cc = (isC ? 1536 : 1024) + 128 * g + 32 * sl + 8 * sg;
    f32x4 w[4][2], bs[2];
#pragma unroll
    for (int h = 0; h < 2; ++h) { bs[h] = *(const f32x4*)(convb + cc + 4 * h);
#pragma unroll
        for (int j = 0; j < 4; ++j) w[j][h] = *(const f32x4*)(convw + j * 2048 + cc + 4 * h); }
    u32x4 r[7], rn[7];
#define BC_LOAD(dst, kb_) do { const int p0_ = 512 * (kb_) + 4 * rg - 3; _Pragma("unroll") for (int j = 0; j < 7; ++j) { const int p_ = p0_ + j; \
        const size_t row_ = p_ >= 0 ? (size_t)(b * SEQ + p_) : (size_t)(MTOK + 16 + p_); dst[j] = *(const u32x4*)(PA + row_ * NPA + C_X + cc); } } while (0)
    BC_LOAD(r, 3);
#pragma unroll 1
    for (int kb = 3; kb >= 0; --kb) {
        if (kb > 0) BC_LOAD(rn, kb - 1);
        asm volatile("s_waitcnt vmcnt(0)" ::: "memory");
        __syncthreads();
#pragma unroll
        for (int h = 0; h < 2; ++h) {
            f32x4 x[7];
#pragma unroll
            for (int j = 0; j < 7; ++j) { const unsigned u0 = r[j][2 * h], u1 = r[j][2 * h + 1]; x[j] = (f32x4){bf_lo(u0), bf_hi(u0), bf_lo(u1), bf_hi(u1)}; }
#pragma unroll
            for (int i = 0; i < 4; ++i) { const f32x4 a = bs[h] + w[0][h] * x[i] + w[1][h] * x[i + 1] + w[2][h] * x[i + 2] + w[3][h] * x[i + 3];
                u32x2 pw; pw.x = cvt_pk_bf16(silu_(a[0]), silu_(a[1])); pw.y = cvt_pk_bf16(silu_(a[2]), silu_(a[3]));
                if (!dry) *(u32x2*)(PA + (size_t)(b * SEQ + 512 * kb + 4 * rg + i) * NPA + C_X + cc + 4 * h) = pw; }
        }
#pragma unroll
        for (int j = 0; j < 7; ++j) r[j] = rn[j];
    }
#undef BC_LOAD
    asm volatile("s_waitcnt vmcnt(0)" ::: "memory");
    __syncthreads();
    if (tid == 0 && !dry) { __builtin_amdgcn_fence(__ATOMIC_RELEASE, "agent"); asm volatile("s_waitcnt vmcnt(0)" ::: "memory"); __hip_atomic_fetch_add(flag, 1u, __ATOMIC_RELAXED, __HIP_MEMORY_SCOPE_AGENT); }
}
__device__ __forceinline__ void bc_conv_wait(unsigned* flag) {
    if (threadIdx.x == 0) { unsigned spins = 0;
        while (__hip_atomic_load(flag, __ATOMIC_RELAXED, __HIP_MEMORY_SCOPE_AGENT) < 8u) { __builtin_amdgcn_s_sleep(4); if (++spins > (1u << 22)) break; }
        __builtin_amdgcn_fence(__ATOMIC_ACQUIRE, "agent"); asm volatile("s_waitcnt vmcnt(0)" ::: "memory"); }
    __syncthreads();
}

struct MixArgs { bf16_t* PA; const float* GATES; float* SSQ; const float *igb, *fgb, *mng, *convw, *convb, *dtb, *alog, *sd, *sng; };

template <bool ML>
__device__ __forceinline__ void mixer_item(LAS unsigned char* L, const MixArgs& A, int item, const int wave_u, bool dry = false) {
    constexpr bool CONV = !ML;
    const int tid = threadIdx.x, lane = tid & 63, w = __builtin_amdgcn_readfirstlane(tid >> 6), fr = lane & 15, fq = lane >> 4;
    const int b = item >> 4;
    int h = 0, sl = 0, head = 0, g = 0;
    if (ML) { h = (item >> 2) & 3; sl = item & 3; } else { head = item & 15; g = head >> 2; }
    const int qcol = ML ? C_Q + 128 * h : C_X + 1536 + 128 * g;
    const int kcol = ML ? C_K + 128 * h : C_X + 1024 + 128 * g;
    const int vcol = ML ? C_V + 256 * h + 64 * sl : C_X + 64 * head;
    const int ocol = ML ? C_O + 256 * h + 64 * sl : C_Z + 64 * head;
    const int gi = ML ? h : 4 + g, part = ML ? sl : (head & 3);
    constexpr int NTL = ML ? 5 : 4;
    const float qscale = ML ? 0.08838834764831845f : 1.0f;
    bf16_t* PA = A.PA;
    LAS bf16_t* Ks = (LAS bf16_t*)(L + OFF_KS); LAS bf16_t* Ps = (LAS bf16_t*)(L + OFF_PS); LAS bf16_t* St = (LAS bf16_t*)(L + OFF_ST);
    LAS bf16_t* Vs = (LAS bf16_t*)(L + OFF_VS); LAS bf16_t* Vw = (LAS bf16_t*)(L + OFF_VW); LAS float* vec = (LAS float*)(L + OFF_VEC); LAS float* cwt = (LAS float*)(L + OFF_CW);
    const unsigned lbase = (unsigned)(uintptr_t)L;
    const int q4 = fr >> 2, p4 = fr & 3, t0 = 16 * w;
    const unsigned vs_tr = lbase + OFF_VS + (8 * fq + q4) * (VP * 2) + 8 * p4;
    const unsigned vw_tr = lbase + OFF_VW + (8 * fq + q4) * (VP * 2) + 8 * p4;
    const unsigned ks_tr = lbase + OFF_KS + (8 * fq + q4) * (KP * 2) + (16 * w + 4 * p4) * 2;
    const int rgq = tid >> 4, segq = tid & 15, rgv = tid >> 3, segv = tid & 7;

    for (int i = tid; i < 80 * KP * 2 / 16; i += NTHREADS) ((LAS u32x4*)St)[i] = (u32x4){0u, 0u, 0u, 0u};
    if (tid == 0) { vec[V_SC] = 0.f; vec[V_SC + 1] = 0.f; }
    if (CONV) {
        for (int i = tid; i < 1600; i += NTHREADS) {
            int r = i, base, W;
            if (r < 640) { base = qcol - C_X; W = 128; } else if (r < 1280) { r -= 640; base = kcol - C_X; W = 128; } else { r -= 1280; base = vcol - C_X; W = 64; }
            const int tap = r / W, col = r - tap * W;
            cwt[i] = tap < 4 ? A.convw[tap * 2048 + base + col] : A.convb[base + col];
        }
    }
    f32x4 sacc[NTL];
#pragma unroll
    for (int n = 0; n < NTL; ++n) sacc[n] = (f32x4){0.f, 0.f, 0.f, 0.f};
    float ib = 0.f, fb = 0.f, dtb = 0.f, Aneg = 0.f, Dh = 0.f;
    if (ML) { ib = A.igb[h]; fb = A.fgb[h]; } else { dtb = A.dtb[head]; Aneg = -__expf(A.alog[head]); Dh = A.sd[head]; }
    float gmulv[4];
#pragma unroll
    for (int n = 0; n < 4; ++n) gmulv[n] = ML ? A.mng[h * 256 + 64 * sl + 16 * n + fr] : A.sng[64 * head + 16 * n + fr];
    Raw<false, 4> RK, RQ; Raw<CONV, 2> RV;
    float gpre[4] = {0.f, 0.f, 0.f, 0.f};
#define MX_ISSUE_Q(cc) issue_task<false, 4>(RQ, PA, b, (cc), rgq, qcol + 8 * segq)
#define MX_ISSUE_KV(cc) do { issue_task<false, 4>(RK, PA, b, (cc), rgq, kcol + 8 * segq); issue_task<CONV, 2>(RV, PA, b, (cc), rgv, vcol + 8 * segv); } while (0)
#define MX_ISSUE_GATES(cc) do { if (w == 0) { _Pragma("unroll") for (int e = 0; e < 2; ++e) { \
                const int p_ = 2 * lane + e; const bool valid_ = ((cc) > 0) || (p_ >= 112); \
                const size_t grow_ = ((cc) == 0) ? (size_t)(MTOK + (valid_ ? p_ - 112 : 0)) : (size_t)(b * SEQ + ((cc) - 1) * 128 + p_); \
                if (ML) { gpre[2 * e] = A.GATES[grow_ * 32 + h]; gpre[2 * e + 1] = A.GATES[grow_ * 32 + 4 + h]; } else { gpre[2 * e] = A.GATES[grow_ * 32 + 8 + head]; } } } } while (0)
    Raw<true, 4> RK0;
    if constexpr (CONV) { issue_task<true, 4>(RK0, PA, b, 0, rgq, kcol + 8 * segq); issue_task<CONV, 2>(RV, PA, b, 0, rgv, vcol + 8 * segv); }
    else { MX_ISSUE_Q(0); MX_ISSUE_KV(0); }
    MX_ISSUE_GATES(0);
    __syncthreads();
    if (w == 0) { const int cc = 0; LAS float* vin = vec; LAS float* vout = vec;
        {
            const float m_prev = (cc > 0) ? vin[V_SC] : 0.f;
            float gl[2], il[2];
#pragma unroll
            for (int e = 0; e < 2; ++e) {
                const int p = 2 * lane + e; const bool valid = (cc > 0) || (p >= 112);
                if (ML) {
                    const float ip = gpre[2 * e] + ib, fp = gpre[2 * e + 1] + fb;
                    const float ic = 15.f * tanhf(ip * (1.f / 15.f)), fc = 15.f * tanhf(fp * (1.f / 15.f));
                    il[e] = valid ? ic : -INFINITY; gl[e] = valid ? -softplus_(-fc) : 0.f;
                } else {
                    const float dt = valid ? softplus_(gpre[2 * e] + dtb) : 0.f;
                    gl[e] = Aneg * dt; il[e] = dt > 0.f ? __logf(dt) : -INFINITY;
                }
            }
            if (cc + 1 < 17) MX_ISSUE_GATES(cc + 1);
            const float s1 = gl[0] + gl[1]; float incl = s1;
#pragma unroll
            for (int o = 1; o < 64; o <<= 1) { const float v = __shfl_up(incl, o); if (lane >= o) incl += v; }
            const float excl = incl - s1, bb0 = excl + gl[0], bb1 = incl, bL = __shfl(incl, 63);
            const float a0 = il[0] - bb0, a1 = il[1] - bb1;
            if (ML) {
                float im = fmaxf(a0, a1);
#pragma unroll
                for (int o = 1; o < 64; o <<= 1) { const float v = __shfl_up(im, o); if (lane >= o) im = fmaxf(im, v); }
                float em = __shfl_up(im, 1); if (lane == 0) em = -INFINITY;
                const float M0 = fmaxf(m_prev, fmaxf(em, a0)), M1v = fmaxf(m_prev, im), Ml = __shfl(M1v, 63);
                vout[V_RT + 2 * lane] = -M0 * L2E; vout[V_RT + 2 * lane + 1] = -M1v * L2E;
                vout[V_CS + 2 * lane] = a0 * L2E; vout[V_CS + 2 * lane + 1] = a1 * L2E;
                vout[V_ET + 2 * lane] = __expf(m_prev - M0) * qscale; vout[V_ET + 2 * lane + 1] = __expf(m_prev - M1v) * qscale;
                vout[V_EMT + 2 * lane] = __expf(-(bb0 + M0)); vout[V_EMT + 2 * lane + 1] = __expf(-(bb1 + M1v));
                vout[V_WS + 2 * lane] = __expf(a0 - Ml); vout[V_WS + 2 * lane + 1] = __expf(a1 - Ml);
                if (lane == 0) { vout[V_SC] = bL + Ml; vout[V_SC + 1] = __expf(m_prev - Ml); }
            } else {
                vout[V_RT + 2 * lane] = bb0 * L2E; vout[V_RT + 2 * lane + 1] = bb1 * L2E;
                vout[V_CS + 2 * lane] = a0 * L2E; vout[V_CS + 2 * lane + 1] = a1 * L2E;
                vout[V_ET + 2 * lane] = __expf(bb0); vout[V_ET + 2 * lane + 1] = __expf(bb1);
                vout[V_WS + 2 * lane] = __expf(bL + a0); vout[V_WS + 2 * lane + 1] = __expf(bL + a1);
                if (lane == 0) { vout[V_SC + 1] = __expf(bL); }
            }
        }
    }
    __syncthreads();
    { LAS float* vnx = vec;
        {
            if constexpr (!CONV) { stage_task<false, 128, 4, false>(RQ, cwt, 8 * segq, Ps, Ps, KP, 4 * rgq, vnx); stage_task<false, 128, 4, false>(RK, cwt, 8 * segq, Ks, Ks, KP, 4 * rgq, vnx); }
            else stage_task<true, 128, 4, false>(RK0, cwt + CW_K, 8 * segq, Ks, Ks, KP, 4 * rgq, vnx);
            stage_task<CONV, 64, 2, false>(RV, cwt + CW_V, 8 * segv, Vs, Vs, VP, 2 * rgv, vnx);
            if (ML && tid < 256) {
                const int s = tid >> 1, half = tid & 1;
                u32x4 o1 = (u32x4){0u, 0u, 0u, 0u};
                if (half == 0) o1.x = 0x3f80u;
                *(LAS u32x4*)(Vs + s * VP + 64 + 8 * half) = o1;
            }
        }
    }
    __syncthreads();

    for (int c = 0; c < 17; ++c) {
        LAS float* vcur = vec + (c & 1) * VEC_FLOATS; LAS float* vnx = vec + ((c + 1) & 1) * VEC_FLOATS;
        const int trow = t0 + 4 * fq; const size_t grow0 = (size_t)b * SEQ + (size_t)(c > 0 ? c - 1 : 0) * 128 + trow;
        bf16_t oz[4][4];
        f32x4 O[NTL];
#pragma unroll
        for (int n = 0; n < NTL; ++n) O[n] = (f32x4){0.f, 0.f, 0.f, 0.f};
        if (c > 0) {
#pragma unroll
            for (int n = 0; n < 4; ++n)
#pragma unroll
                for (int r = 0; r < 4; ++r) oz[n][r] = PA[(grow0 + r) * NPA + ocol + 16 * n + fr];
            bf16x8 qf[4];
#pragma unroll
            for (int ks = 0; ks < 4; ++ks) qf[ks] = *(const LAS bf16x8*)(Ps + (t0 + fr) * KP + 32 * ks + 8 * fq);
            LDS_WAIT();
            const float rtv = vcur[V_RT + t0 + fr]; const int t = t0 + fr;
#pragma unroll 1
            for (int i = 0; i <= w; ++i) {
                f32x4 sa = (f32x4){0.f, 0.f, 0.f, 0.f};
#pragma unroll
                for (int ks = 0; ks < 4; ++ks) { const bf16x8 kf = *(const LAS bf16x8*)(Ks + (16 * i + fr) * KP + 32 * ks + 8 * fq); sa = mfma16(kf, qf[ks], sa); }
                const f32x4 cs = *(const LAS f32x4*)(vcur + V_CS + 16 * i + 4 * fq);
                float pv[4];
#pragma unroll
                for (int r = 0; r < 4; ++r) { const int s = 16 * i + 4 * fq + r; const float e = __builtin_amdgcn_exp2f(rtv + cs[r]); pv[r] = (s <= t) ? sa[r] * qscale * e : 0.f; }
                u32x2 pw; pw.x = cvt_pk_bf16(pv[0], pv[1]); pw.y = cvt_pk_bf16(pv[2], pv[3]);
                *(LAS u32x2*)(Ps + t * KP + 16 * i + 4 * fq) = pw;
            }
            if (w < 7) *(LAS u32x2*)(Ps + t * KP + 16 * (w + 1) + 4 * fq) = (u32x2){0u, 0u};
            LDS_WAIT();
#pragma unroll
            for (int ks = 0; ks < 4; ++ks) {
#pragma unroll
                for (int n = 0; n < NTL; ++n) { const bf16x8 sb = *(const LAS bf16x8*)(St + (16 * n + fr) * KP + 32 * ks + 8 * fq); O[n] = mfma16(qf[ks], sb, O[n]); }
                asm volatile("" ::: "memory");
            }
            const f32x4 etv = *(const LAS f32x4*)(vcur + V_ET + t0 + 4 * fq);
#pragma unroll
            for (int n = 0; n < NTL; ++n) O[n] = O[n] * etv;
        }
        {
            const float adec = vcur[V_SC + 1];
#pragma unroll
            for (int n = 0; n < NTL; ++n) sacc[n] = sacc[n] * adec;
#pragma unroll 1
            for (int kk = 0; kk < 4; ++kk) {
                bf16x8 vb[NTL]; tr_frags<NTL, 4 * VP * 2>(vs_tr + kk * (32 * VP * 2), vb);
                if (c > 0 && kk <= (w >> 1)) {
                    const bf16x8 pa = *(const LAS bf16x8*)(Ps + (t0 + fr) * KP + 32 * kk + 8 * fq);
#pragma unroll
                    for (int n = 0; n < NTL; ++n) O[n] = mfma16(pa, vb[n], O[n]);
                }
                const bf16x8 kr = tr_frag<4 * KP * 2>(ks_tr + kk * (32 * KP * 2));
                const f32x4 w0 = *(const LAS f32x4*)(vcur + V_WS + 32 * kk + 8 * fq), w1 = *(const LAS f32x4*)(vcur + V_WS + 32 * kk + 8 * fq + 4);
                float kf[8]; unpack8(__builtin_bit_cast(u32x4, kr), kf);
                kf[0] *= w0[0]; kf[1] *= w0[1]; kf[2] *= w0[2]; kf[3] *= w0[3]; kf[4] *= w1[0]; kf[5] *= w1[1]; kf[6] *= w1[2]; kf[7] *= w1[3];
                const u32x4 kw = pack8(kf); const bf16x8 ka = __builtin_bit_cast(bf16x8, kw);
#pragma unroll
                for (int n = 0; n < NTL; ++n) sacc[n] = mfma16(ka, vb[n], sacc[n]);
            }
        }
        if (c + 1 < 17) { MX_ISSUE_Q(c + 1); MX_ISSUE_KV(c + 1); }
        if (c > 0) {
            float inv[4] = {1.f, 1.f, 1.f, 1.f};
            if (ML) { const f32x4 em = *(const LAS f32x4*)(vcur + V_EMT + trow);
#pragma unroll
                for (int r = 0; r < 4; ++r) { const float den = __shfl(O[NTL - 1][r], lane & 48); inv[r] = 1.0f / fmaxf(fabsf(den), em[r]); } }
            float ssq[4] = {0.f, 0.f, 0.f, 0.f};
#pragma unroll
            for (int n = 0; n < 4; ++n) {
                const int col = 16 * n + fr;
                const float gmul = gmulv[n];
#pragma unroll
                for (int r = 0; r < 4; ++r) {
                    bf16_t* addr = PA + (grow0 + r) * NPA + ocol + col; float val;
                    if (ML) { const float hraw = O[n][r] * inv[r]; ssq[r] += hraw * hraw; val = hraw * gmul * sigmoid_(bf1(oz[n][r])); }
                    else { const float x = bf1(Vs[(trow + r) * VP + col]); const float yg = (O[n][r] + Dh * x) * silu_(bf1(oz[n][r])); ssq[r] += yg * yg; val = yg * gmul; }
                    if (!dry) *addr = f2bf(val);
                }
            }
#pragma unroll
            for (int r = 0; r < 4; ++r) { float s = ssq[r]; s += __shfl_xor(s, 1); s += __shfl_xor(s, 2); s += __shfl_xor(s, 4); s += __shfl_xor(s, 8);
                if (fr == 0 && !dry) A.SSQ[((grow0 + r) * 8 + gi) * 4 + part] = s; }
        }
        if (c + 1 < 17) {
            if (w == 0) { const int cc = c + 1; LAS float* vin = vcur; LAS float* vout = vnx;
        {
                const float m_prev = (cc > 0) ? vin[V_SC] : 0.f;
                float gl[2], il[2];
#pragma unroll
                for (int e = 0; e < 2; ++e) {
                    const int p = 2 * lane + e; const bool valid = (cc > 0) || (p >= 112);
                    if (ML) {
                        const float ip = gpre[2 * e] + ib, fp = gpre[2 * e + 1] + fb;
                        const float ic = 15.f * tanhf(ip * (1.f / 15.f)), fc = 15.f * tanhf(fp * (1.f / 15.f));
                        il[e] = valid ? ic : -INFINITY; gl[e] = valid ? -softplus_(-fc) : 0.f;
                    } else {
                        const float dt = valid ? softplus_(gpre[2 * e] + dtb) : 0.f;
                        gl[e] = Aneg * dt; il[e] = dt > 0.f ? __logf(dt) : -INFINITY;
                    }
                }
                if (cc + 1 < 17) MX_ISSUE_GATES(cc + 1);
                const float s1 = gl[0] + gl[1]; float incl = s1;
#pragma unroll
                for (int o = 1; o < 64; o <<= 1) { const float v = __shfl_up(incl, o); if (lane >= o) incl += v; }
                const float excl = incl - s1, bb0 = excl + gl[0], bb1 = incl, bL = __shfl(incl, 63);
                const float a0 = il[0] - bb0, a1 = il[1] - bb1;
                if (ML) {
                    float im = fmaxf(a0, a1);
#pragma unroll
                    for (int o = 1; o < 64; o <<= 1) { const float v = __shfl_up(im, o); if (lane >= o) im = fmaxf(im, v); }
                    float em = __shfl_up(im, 1); if (lane == 0) em = -INFINITY;
                    const float M0 = fmaxf(m_prev, fmaxf(em, a0)), M1v = fmaxf(m_prev, im), Ml = __shfl(M1v, 63);
                    vout[V_RT + 2 * lane] = -M0 * L2E; vout[V_RT + 2 * lane + 1] = -M1v * L2E;
                    vout[V_CS + 2 * lane] = a0 * L2E; vout[V_CS + 2 * lane + 1] = a1 * L2E;
                    vout[V_ET + 2 * lane] = __expf(m_prev - M0) * qscale; vout[V_ET + 2 * lane + 1] = __expf(m_prev - M1v) * qscale;
                    vout[V_EMT + 2 * lane] = __expf(-(bb0 + M0)); vout[V_EMT + 2 * lane + 1] = __expf(-(bb1 + M1v));
                    vout[V_WS + 2 * lane] = __expf(a0 - Ml); vout[V_WS + 2 * lane + 1] = __expf(a1 - Ml);
                    if (lane == 0) { vout[V_SC] = bL + Ml; vout[V_SC + 1] = __expf(m_prev - Ml); }
                } else {
                    vout[V_RT + 2 * lane] = bb0 * L2E; vout[V_RT + 2 * lane + 1] = bb1 * L2E;
                    vout[V_CS + 2 * lane] = a0 * L2E; vout[V_CS + 2 * lane + 1] = a1 * L2E;
                    vout[V_ET + 2 * lane] = __expf(bb0); vout[V_ET + 2 * lane + 1] = __expf(bb1);
                    vout[V_WS + 2 * lane] = __expf(bL + a0); vout[V_WS + 2 * lane + 1] = __expf(bL + a1);
                    if (lane == 0) { vout[V_SC + 1] = __expf(bL); }
                }
            }
            }
        }
        __syncthreads();
#pragma unroll
        for (int n = 0; n < NTL; ++n) { u32x2 sw; sw.x = cvt_pk_bf16(sacc[n][0], sacc[n][1]); sw.y = cvt_pk_bf16(sacc[n][2], sacc[n][3]);
            *(LAS u32x2*)(St + (16 * n + fr) * KP + 16 * w + 4 * fq) = sw; }
        if (c + 1 < 17) {
        {
                stage_task<false, 128, 4, false>(RQ, cwt, 8 * segq, Ps, Ps, KP, 4 * rgq, vnx);
                stage_task<false, 128, 4, false>(RK, cwt, 8 * segq, Ks, Ks, KP, 4 * rgq, vnx);
                stage_task<CONV, 64, 2, false>(RV, cwt + CW_V, 8 * segv, Vs, Vs, VP, 2 * rgv, vnx);
                if (ML && tid < 256) {
                    const int s = tid >> 1, half = tid & 1;
                    u32x4 o1 = (u32x4){0u, 0u, 0u, 0u};
                    if (half == 0) o1.x = 0x3f80u;
                    *(LAS u32x4*)(Vs + s * VP + 64 + 8 * half) = o1;
                }
            }
        }
        __syncthreads();
    }
    __syncthreads();
}
#undef MX_ISSUE_Q
#undef MX_ISSUE_KV
#undef MX_ISSUE_GATES
}

#define XB_TMO      128
#define XB_XCNT(j)  (256  + 64 * (j))
#define XB_XSUB(j)  (1280 + 64 * (j))
#define XB_XGEN(j)  (2304 + 64 * (j))
#define XB_TOP      3328
#define XB_TOPGEN   3392
#define XCD_BAR_WORDS 3456
#define XB_SPIN_CAP (1u << 18)

__device__ __forceinline__ unsigned xb_ld(unsigned* p)              { return __hip_atomic_load(p, __ATOMIC_RELAXED, __HIP_MEMORY_SCOPE_AGENT); }
__device__ __forceinline__ unsigned xb_add(unsigned* p, unsigned v) { return __hip_atomic_fetch_add(p, v, __ATOMIC_RELAXED, __HIP_MEMORY_SCOPE_AGENT); }
__device__ __forceinline__ unsigned xb_xcc_id() { return (unsigned)__builtin_amdgcn_s_getreg((3 << 11) | 20) & 0xFu; }
#define XB_SPIN(cond, bar) do { unsigned _sp = 0; while (cond) { __builtin_amdgcn_s_sleep(1); \
    if ((++_sp & 255u) == 0u) { if (xb_ld(&(bar)[XB_TMO])) break; if (_sp > XB_SPIN_CAP) { atomicAdd(&(bar)[XB_TMO], 1u); break; } } } } while (0)

struct XcdBarrier {
    unsigned* bar; unsigned x;
    volatile LAS unsigned* st;
};

__device__ __forceinline__ XcdBarrier xcd_barrier_post(unsigned* bar, volatile LAS unsigned* st) {
    XcdBarrier b; b.bar = bar; b.x = xb_xcc_id(); b.st = st;
    if (threadIdx.x == 0) (void)xb_add(&bar[XB_XCNT(b.x)], 1u);
    return b;
}
__device__ __forceinline__ void xcd_barrier_complete(unsigned* bar, unsigned x, unsigned& nloc, unsigned& nx) {
    const unsigned G = gridDim.x * gridDim.y * gridDim.z;
    unsigned sum, cnt, mine, sp = 0u;
    for (;;) {
        sum = 0u; cnt = 0u; mine = 0u;
#pragma unroll
        for (unsigned j = 0; j < 16; ++j) { const unsigned c = xb_ld(&bar[XB_XCNT(j)]); sum += c; cnt += (c > 0u) ? 1u : 0u; mine = (j == x) ? c : mine; }
        if (sum == G) break;
        __builtin_amdgcn_s_sleep(1);
        if ((++sp & 255u) == 0u) { if (xb_ld(&bar[XB_TMO])) break; if (sp > XB_SPIN_CAP) { atomicAdd(&bar[XB_TMO], 1u); break; } }
    }
    nloc = mine > 0u ? mine : 1u; nx = cnt > 0u ? cnt : 1u;
}

__device__ __forceinline__ void xcd_barrier(const XcdBarrier& b, const bool is_t0) {
    asm volatile("s_waitcnt vmcnt(0)" ::: "memory");
    __syncthreads();
    if (is_t0) {
        unsigned* bar = b.bar;
        __builtin_amdgcn_s_waitcnt(0);
        unsigned nloc = b.st[0], nx = b.st[1];
        if (nloc == 0u) { xcd_barrier_complete(bar, b.x, nloc, nx); b.st[0] = nloc; b.st[1] = nx; }
        const unsigned old = xb_add(&bar[XB_XSUB(b.x)], 1u);
        const unsigned gen = old / nloc;
        if (old + 1u == (gen + 1u) * nloc) {
            __builtin_amdgcn_fence(__ATOMIC_RELEASE, "agent");
            asm volatile("s_waitcnt vmcnt(0)" ::: "memory");
            const unsigned og = xb_add(&bar[XB_TOP], 1u);
            const unsigned tg = og / nx;
            if (og + 1u == (tg + 1u) * nx) xb_add(&bar[XB_TOPGEN], 1u);
            else XB_SPIN(xb_ld(&bar[XB_TOPGEN]) == tg, bar);
            __builtin_amdgcn_fence(__ATOMIC_ACQUIRE, "agent");
            xb_add(&bar[XB_XGEN(b.x)], 1u);
            asm volatile("s_waitcnt vmcnt(0)" ::: "memory");
        } else {
            XB_SPIN(xb_ld(&bar[XB_XGEN(b.x)]) == gen, bar);
            __builtin_amdgcn_fence(__ATOMIC_ACQUIRE, "agent");
            asm volatile("s_waitcnt vmcnt(0)" ::: "memory");
        }
    }
    __syncthreads();
}

__global__ void __launch_bounds__(NTHREADS, 2) fwd_kernel(Args a) {
    extern __shared__ __attribute__((aligned(16))) unsigned char lds[];
    cg::grid_group grid = cg::this_grid();
    LAS unsigned char* L = (LAS unsigned char*)lds;
    const int tid = threadIdx.x, lane = tid & 63, wave = __builtin_amdgcn_readfirstlane(tid >> 6);
    const int G = gridDim.x, bx = blockIdx.x;
    const int vcu = (G % 8 == 0) ? (bx % 8) * (G / 8) + bx / 8 : bx;
    const int gw = vcu * NWAVES + wave, NGW = G * NWAVES;
    unsigned char* ws = a.ws;
    bf16_t* PA = (bf16_t*)(ws + OFF_PA); bf16_t* U = (bf16_t*)(ws + OFF_U); bf16_t* WIN = (bf16_t*)(ws + OFF_WIN);
    float* GATES = (float*)(ws + OFF_GATES); float* SSQ = (float*)(ws + OFF_SSQ); float* SSQ2 = (float*)(ws + OFF_SSQ2); float* SSQ3 = (float*)(ws + OFF_SSQ3);
    bf16_t* WM = (bf16_t*)(ws + OFF_WM); bf16_t* WSP = (bf16_t*)(ws + OFF_WS); bf16_t* WO = (bf16_t*)(ws + OFF_WO); bf16_t* WFI = (bf16_t*)(ws + OFF_WFI); bf16_t* WFO = (bf16_t*)(ws + OFF_WFO);
    bf16_t* PB = (bf16_t*)a.out; float* OUT = a.out;
    LAS float* scr = (LAS float*)(L + wave * 8448);
    volatile LAS unsigned* MISC = (volatile LAS unsigned*)(L + LDS_BYTES - 16);
    if (tid < 2) MISC[tid] = 0u;
    LAS unsigned long long* PT = (LAS unsigned long long*)(L + LDS_BYTES - 16 - 256);
    if (tid < 20) PT[tid] = (unsigned long long)a.in[tid];
    __syncthreads();
#define INP(i) ((const float*)(((unsigned long long)(unsigned)__builtin_amdgcn_readfirstlane((int)(unsigned)(PT[i] >> 32)) << 32) | (unsigned long long)(unsigned)__builtin_amdgcn_readfirstlane((int)(unsigned)PT[i])))
    XcdBarrier xbar = xcd_barrier_post((unsigned*)(ws + WS_END + 4096), MISC);
#define GRID_BAR() xcd_barrier(xbar, threadIdx.x == 0)
#ifdef PROBE_T
    unsigned long long* TS = (unsigned long long*)(ws + WS_END); int n_ts = 0;
#define STAMP() do { if (bx == 0 && tid == 0) TS[n_ts] = __builtin_amdgcn_s_memrealtime(); ++n_ts; } while (0)
    STAMP();
#else
#define STAMP() do {} while (0)
#endif

#ifdef PROBE_P0X2
    for (int rep_ = 0; rep_ < 2; ++rep_) {
#else
    {
#endif
    for (int it = gw; it < 16 * 264; it += 2 * NGW) { if (it + NGW < 16 * 264) transpose_items2(INP(I_WIN), INW, DM, WIN, 1, scr, it, it + NGW, 264, lane); else transpose_item(INP(I_WIN), INW, DM, WIN, 1, nullptr, scr, it, 264, lane); }
    for (int m = gw; m < MTOK; m += 2 * NGW) rms_rows2_to_bf16(INP(I_X) + (size_t)m * DM, INP(I_X) + (size_t)(m + NGW) * DM, INP(I_N1G), U + (size_t)m * DM, U + (size_t)(m + NGW) * DM, lane);
    for (int m = MTOK + gw; m < M1; m += NGW) {
        if (m < MTOK + 16) rms_row_to_bf16(INP(I_META) + (size_t)(m - MTOK) * DM, INP(I_N1G), U + (size_t)m * DM, lane);
        else { u32x4* o = (u32x4*)(U + (size_t)m * DM) + lane; o[0] = (u32x4){0u, 0u, 0u, 0u}; o[64] = (u32x4){0u, 0u, 0u, 0u}; }
    }
    }
    GRID_BAR(); STAMP();
    if (a.ws == nullptr) grid.sync();
#ifdef PROBE_SYNC2
    grid.sync();
#endif
    {
        pg8::Gemm g{U, WIN, M1, N1, DM, DM}; pg8::StaticOrder S; S.init(M1, N1, G, bx);
        EpiProj E{PA, PB, GATES};
#ifndef NO_EpiProj
        pg8::gemm_phase<EpiProj, pg8::StaticOrder, true, true>(L, g, S, E, wave);
#endif
#ifdef PROBE_G1X2
        pg8::gemm_phase<EpiProj, pg8::StaticOrder, true, true>(L, g, S, E, wave);
#endif
    }
    GRID_BAR(); STAMP();
#ifdef PROBE_SYNC2
    GRID_BAR(); GRID_BAR();
#endif
    {
        __syncthreads();
        mx::MixArgs MA{PA, GATES, SSQ, INP(I_IGB), INP(I_FGB), INP(I_MNG), INP(I_CONVW), INP(I_CONVB), INP(I_DTB), INP(I_ALOG), INP(I_SD), INP(I_SNG)};
#ifdef PROBE_MIXA2
        for (int item = vcu; item < 128; item += G) mx::mixer_item<true>(L, MA, item, wave, true);
        asm volatile("" ::: "memory");
#endif
#ifdef PROBE_MIXB2
        for (int item = (vcu < 128 ? vcu + ((127 - vcu) / G + 1) * G : vcu); item < 256; item += G) mx::mixer_item<false>(L, MA, item - 128, wave, true);
        asm volatile("" ::: "memory");
#endif
#if defined(PROBE_MIXA2) || defined(PROBE_MIXB2)
        __syncthreads(); GRID_BAR();
#endif
        unsigned* FL = (unsigned*)(ws + WS_END + 4096 + 16384);
#ifdef PROBE_BC2
        for (int pt = vcu; pt < 256; pt += G) mx::bc_conv_pass(PA, pt >> 5, (pt >> 3) & 3, (pt >> 1) & 3, pt & 1, INP(I_CONVW), INP(I_CONVB), FL + 16 * (pt >> 3), true);
        __syncthreads(); GRID_BAR();
#endif
        for (int pt = vcu; pt < 256; pt += G) mx::bc_conv_pass(PA, pt >> 5, (pt >> 3) & 3, (pt >> 1) & 3, pt & 1, INP(I_CONVW), INP(I_CONVB), FL + 16 * (pt >> 3));
#ifndef NO_MIXA
        for (int item = vcu; item < 128; item += G) mx::mixer_item<true>(L, MA, item, wave);
#endif
        for (int it = vcu * NWAVES + wave; it < 4032 && vcu < 128; it += 128 * NWAVES) {
            int r = it;
            if (r < 512) { transpose_item(INP(I_MPROJ), DM, DM, WM, 0, nullptr, scr, r, 32, lane); continue; } r -= 512;
            if (r < 512) { transpose_item(INP(I_SPROJ), DM, DM, WSP, 0, nullptr, scr, r, 32, lane); continue; } r -= 512;
            if (r < 512) { transpose_item(INP(I_WOUT), DM, DM, WO, 0, nullptr, scr, r, 32, lane); continue; } r -= 512;
            if (r < 2816) { transpose_item(INP(I_WFI), 2 * DFF, DM, WFI, 2, INP(I_N2G), scr, r, 176, lane); continue; } r -= 2816;
            transpose_item(INP(I_WFO), DM, DFF, WFO, 0, nullptr, scr, r, 32, lane);
        }
        asm volatile("" ::: "memory");
#ifndef NO_MIXB
        for (int item = (vcu < 128 ? vcu + ((127 - vcu) / G + 1) * G : vcu); item < 256; item += G) {
            mx::bc_conv_wait(FL + 16 * (((item - 128) >> 4) * 4 + (((item - 128) & 15) >> 2)));
            mx::mixer_item<false>(L, MA, item - 128, wave);
        }
#endif
        for (int it = 4032 + (vcu - 128) * NWAVES + wave; it < 5760 && vcu >= 128; it += 128 * NWAVES) {
            int r = it - 4352;
            if (r < 0) { transpose_item(INP(I_WFI), 2 * DFF, DM, WFI, 2, INP(I_N2G), scr, it - 1536, 176, lane); continue; }
            transpose_item(INP(I_WFO), DM, DFF, WFO, 0, nullptr, scr, r, 32, lane);
        }
    }
    GRID_BAR(); STAMP();
#ifdef PROBE_SYNC2
    GRID_BAR(); GRID_BAR();
#endif
    {
        pg8::StaticOrder S; S.init(MTOK, DM, G, bx);
        LAS float* RT = (LAS float*)(L + 131072);
        pg8::Unit u0;
        if (S.next(0, u0)) {
            const int lr = tid >> 1, g0 = (tid & 1) * 4; const size_t row = (size_t)u0.pm * 256 + lr;
            float ms[4];
#pragma unroll
            for (int i = 0; i < 4; ++i) { const f32x4 s = *(const f32x4*)(SSQ + (row * 8 + g0 + i) * 4); ms[i] = ((s[0] + s[1]) + (s[2] + s[3])) * (1.0f / 256.f) + EPS; }
#pragma unroll
            for (int i = 1; i < 4; ++i) RT[lr * 8 + g0 + i] = sqrtf(ms[i] * __builtin_amdgcn_rcpf(ms[i - 1]));
            RT[lr * 8 + g0] = 1.0f / sqrtf(ms[3]);
        }
        __syncthreads();
        {
            pg8::Gemm g{PA + C_O, WM, MTOK, DM, DM, NPA};
            EpiBranchA E{PA, PB, RT}; HookRow H{RT, 0};
#ifndef NO_EpiBranchA
            pg8::gemm_phase<EpiBranchA, pg8::StaticOrder, true, true, HookRow>(L, g, S, E, wave, H);
#endif
        }
        {
            pg8::Gemm g{PA + C_Z, WSP, MTOK, DM, DM, NPA};
            EpiBranchB E{PB, PA, RT}; HookRow H{RT, 4};
#ifndef NO_EpiBranchB
            pg8::gemm_phase<EpiBranchB, pg8::StaticOrder, true, true, HookRow>(L, g, S, E, wave, H);
#endif
        }
    }
    GRID_BAR(); STAMP();
#ifdef PROBE_SYNC2
    GRID_BAR(); GRID_BAR();
#endif
    {
        pg8::Gemm g{PA + C_MERGED, WO, MTOK, DM, DM, NPA}; pg8::StaticOrder S; S.init(MTOK, DM, G, bx);
        EpiOut E{INP(I_X), OUT, PA, SSQ2};
#ifndef NO_EpiOut
        pg8::gemm_phase<EpiOut, pg8::StaticOrder, true, true>(L, g, S, E, wave);
#endif
#ifdef PROBE_G4X2
        pg8::gemm_phase<EpiOut, pg8::StaticOrder, true, true>(L, g, S, E, wave);
#endif
    }
    GRID_BAR(); STAMP();
#ifdef PROBE_SYNC2
    GRID_BAR(); GRID_BAR();
#endif
    {
        pg8::Gemm g{PA + C_H1B, WFI, MTOK, 2 * DFF, DM, NPA}; pg8::StaticOrder S; S.init(MTOK, 2 * DFF, G, bx);
        EpiFfnIn E{SSQ2, PA};
#ifndef NO_EpiFfnIn
        pg8::gemm_phase<EpiFfnIn, pg8::StaticOrder, true, true>(L, g, S, E, wave);
#endif
#ifdef PROBE_G5X2
        pg8::gemm_phase<EpiFfnIn, pg8::StaticOrder, true, true>(L, g, S, E, wave);
#endif
    }
    GRID_BAR(); STAMP();
#ifdef PROBE_SYNC2
    GRID_BAR(); GRID_BAR();
#endif
    {
        pg8::Gemm g{PA + C_ACT, WFO, MTOK, DM, DFF, NPA}; pg8::StaticOrder S; S.init(MTOK, DM, G, bx);
        EpiFfnOutNorm E{OUT, SSQ3, (unsigned*)(ws + WS_END + 32768), INP(I_NFG), PA};
        pg8::gemm_phase<EpiFfnOutNorm, pg8::StaticOrder, false, true>(L, g, S, E, wave);
    }
#ifdef PROBE_T
    GRID_BAR(); STAMP();
#ifdef PROBE_SYNC2
    GRID_BAR(); GRID_BAR();
#endif
    if (bx == 0) {
        const float da = (float)(TS[PROBE_A + 1] - TS[PROBE_A]) * 0.01f, db = (float)(TS[PROBE_B + 1] - TS[PROBE_B]) * 0.01f;
        if (tid == 0) OUT[0] = 50.f * da;
        for (int i = tid; i < (1 << 20); i += NTHREADS) OUT[1024 + i] = 0.25f * db;
    }
#endif
}

#undef INP
extern "C" void kernel_launch(void* const* d_in, const int* in_sizes, int n_in, void* d_out, int out_size, void* d_ws, size_t ws_size, hipStream_t stream) {
    static int grid = 0;
    if (grid == 0) {
        if (n_in != 20 || out_size != MTOK * DM || ws_size < WS_END) { fprintf(stderr, "kernel_launch: unexpected shapes (n_in %d out %d ws %zu)\n", n_in, out_size, ws_size); grid = -1; return; }
        int dev = 0, cus = 0, per_cu = 0;
        (void)hipGetDevice(&dev); (void)hipDeviceGetAttribute(&cus, hipDeviceAttributeMultiprocessorCount, dev);
        if (hipFuncSetAttribute((const void*)fwd_kernel, hipFuncAttributeMaxDynamicSharedMemorySize, LDS_BYTES) != hipSuccess) { fprintf(stderr, "kernel_launch: hipFuncSetAttribute failed\n"); grid = -1; return; }
        if (hipOccupancyMaxActiveBlocksPerMultiprocessor(&per_cu, (const void*)fwd_kernel, NTHREADS, LDS_BYTES) != hipSuccess || per_cu < 1) { fprintf(stderr, "kernel_launch: occupancy query gave %d\n", per_cu); per_cu = 1; }
        (void)hipGetLastError();
        grid = cus * 1;
        if (grid <= 0) grid = 256;
    }
    if (grid < 0) return;
    Args a{};
    for (int i = 0; i < 20; ++i) a.in[i] = (const float*)d_in[i];
    a.out = (float*)d_out; a.ws = (unsigned char*)d_ws;
    (void)hipMemsetAsync((unsigned char*)d_ws + WS_END + 4096, 0, 28672 + 64 * 256, stream);
    void* args[] = {&a};
    const hipError_t e = hipLaunchCooperativeKernel((const void*)fwd_kernel, dim3(grid), dim3(NTHREADS), args, LDS_BYTES, stream);
    if (e != hipSuccess) fprintf(stderr, "kernel_launch: cooperative launch failed: %s (grid %d)\n", hipGetErrorString(e), grid);
}
```
